# Optimizing an MI355X kernel written in HIP

```python
import numpy as np
import jax
import jax.numpy as jnp
from jax import lax

D_MODEL = 2048
BATCH = 4
SEQ = 4096
DEPTH = 2

HEAD_DIM = 128
N_HEADS = D_MODEL // HEAD_DIM
N_HEADS_FOX = N_HEADS // 2
N_HEADS_DIL = N_HEADS - N_HEADS_FOX
DILATED_PATTERNS = ((128, 1), (512, 4), (2048, 16))
N_HEADS_NSA = N_HEADS
N_KV_NSA = 4
CMP_BLOCK = 32
CMP_STRIDE = 16
SLC_BLOCK = 64
N_SELECT = 16
WINDOW_NSA = 512
Q_BLOCK = 128
NSA_Q_BLOCK = 32
ROPE_THETA = 500000.0
ROPE_DIM = HEAD_DIM // 4
D_FF = 4 * D_MODEL
EPS = 1e-6
NEG = -1e30
FORCED_SCORE = 1e9
SCALE = HEAD_DIM ** -0.5
N_EVEN = (DEPTH + 1) // 2
N_ODD = DEPTH // 2

FOX_W = N_HEADS_FOX * HEAD_DIM
DIL_W = N_HEADS_DIL * HEAD_DIM
EVEN_IN = 4 * FOX_W + N_HEADS_FOX + 3 * DIL_W
Q_NSA_W = N_HEADS_NSA * HEAD_DIM
KV_NSA_W = N_KV_NSA * HEAD_DIM
ODD_IN = Q_NSA_W + 6 * KV_NSA_W + 3 * N_HEADS_NSA

kernel_name = 'hybrid_fox_dilated_nsa_trunk'


def rms_norm(x, g):
    xf = x.astype(jnp.float32)
    y = xf * lax.rsqrt(jnp.mean(xf * xf, axis=-1, keepdims=True) + EPS)
    return (y * g.astype(jnp.float32)).astype(x.dtype)


def rope_tables(pos):
    inv = 1.0 / (ROPE_THETA ** (jnp.arange(0, ROPE_DIM, 2, dtype=jnp.float32) / ROPE_DIM))
    ang = pos.astype(jnp.float32)[..., None] * inv
    return jnp.cos(ang), jnp.sin(ang)


def partial_rope(x, cos, sin):
    half = ROPE_DIM // 2
    x1 = x[..., :half]
    x2 = x[..., half:ROPE_DIM]
    c = cos.astype(x.dtype)
    s = sin.astype(x.dtype)
    return jnp.concatenate([x1 * c - x2 * s, x2 * c + x1 * s, x[..., ROPE_DIM:]], axis=-1)


def masked_softmax(s, mask):
    s = jnp.where(mask, s.astype(jnp.float32), NEG)
    m = jnp.max(s, axis=-1, keepdims=True)
    e = jnp.where(mask, jnp.exp(s - m), 0.0)
    return e / jnp.maximum(jnp.sum(e, axis=-1, keepdims=True), 1e-30)


def sq_relu_mlp(h, w_up, w_down):
    return jnp.square(jax.nn.relu(h @ w_up)) @ w_down


def fox_attention(q, k, v, log_f):
    B, H, S, Dh = q.shape
    c = jnp.cumsum(log_f, axis=-1)
    nb = S // Q_BLOCK
    qb = jnp.moveaxis(q.reshape(B, H, nb, Q_BLOCK, Dh), 2, 0)
    cb = jnp.moveaxis(c.reshape(B, H, nb, Q_BLOCK), 2, 0)
    kpos = jnp.arange(S)

    def block(args):
        i, qi, ci = args
        s = jnp.einsum('bhqd,bhkd->bhqk', qi, k).astype(jnp.float32) * SCALE
        s = s + ci[..., :, None] - c[..., None, :]
        qpos = i * Q_BLOCK + jnp.arange(Q_BLOCK)
        p = masked_softmax(s, kpos[None, :] <= qpos[:, None])
        return jnp.einsum('bhqk,bhkd->bhqd', p, v)

    o = lax.map(block, (jnp.arange(nb), qb, cb))
    return jnp.moveaxis(o, 0, 2).reshape(B, H, S, Dh)


def dilated_pattern(q, k, v, dilation, steps):
    B, H, S, Dh = q.shape
    L = S // dilation
    qb = min(Q_BLOCK, L)
    nb = -(-L // qb)
    pad_r = nb * qb - L

    def to_sub(t):
        return t.reshape(B, H, L, dilation, Dh).transpose(0, 1, 3, 2, 4)

    pad_q = ((0, 0), (0, 0), (0, 0), (0, pad_r), (0, 0))
    pad_k = ((0, 0), (0, 0), (0, 0), (qb, pad_r), (0, 0))
    qs = jnp.pad(to_sub(q), pad_q).reshape(B, H, dilation, nb, qb, Dh)
    kp = jnp.pad(to_sub(k), pad_k).reshape(B, H, dilation, nb + 1, qb, Dh)
    vp = jnp.pad(to_sub(v), pad_k).reshape(B, H, dilation, nb + 1, qb, Dh)
    kw = jnp.concatenate([kp[:, :, :, :-1], kp[:, :, :, 1:]], axis=4)
    vw = jnp.concatenate([vp[:, :, :, :-1], vp[:, :, :, 1:]], axis=4)
    s = jnp.einsum('bhrnqd,bhrnkd->bhrnqk', qs, kw).astype(jnp.float32) * SCALE
    qm = (jnp.arange(nb) * qb)[:, None] + jnp.arange(qb)[None, :]
    km = (jnp.arange(nb) * qb - qb)[:, None] + jnp.arange(2 * qb)[None, :]
    dist = qm[:, :, None] - km[:, None, :]
    mask = (dist >= 0) & (dist <= steps) & (km[:, None, :] >= 0)
    s = jnp.where(mask, s, NEG)
    m = jnp.max(s, axis=-1)
    e = jnp.where(mask, jnp.exp(s - m[..., None]), 0.0)
    den = jnp.sum(e, axis=-1)
    num = jnp.einsum('bhrnqk,bhrnkd->bhrnqd', e, vw.astype(jnp.float32))

    def from_sub(t):
        rest = t.shape[5:]
        t = t.reshape((B, H, dilation, nb * qb) + rest)[:, :, :, :L]
        t = jnp.moveaxis(t, 2, 3)
        return t.reshape((B, H, S) + rest)

    return from_sub(m), from_sub(den), from_sub(num)


def dilated_attention(q, k, v):
    parts = [dilated_pattern(q, k, v, d, w // d) for (w, d) in DILATED_PATTERNS]
    m_all = jnp.max(jnp.stack([p[0] for p in parts]), axis=0)
    den = None
    num = None
    for m, l, n in parts:
        w = jnp.exp(m - m_all)
        den = w * l if den is None else den + w * l
        num = w[..., None] * n if num is None else num + w[..., None] * n
    return num / den[..., None]


def even_mixer(h, w_in, b_f, w_out, g_q_fox, g_k_fox, g_q_dil, g_k_dil, cos, sin):
    B, S, _ = h.shape
    proj = h @ w_in
    splits = np.cumsum([FOX_W, FOX_W, FOX_W, FOX_W, N_HEADS_FOX, DIL_W, DIL_W]).tolist()
    qa, ka, va, ga, fa, qd, kd, vd = jnp.split(proj, splits, axis=-1)

    def heads(t, n):
        return t.reshape(B, S, n, HEAD_DIM)

    def bhsd(t):
        return t.transpose(0, 2, 1, 3)

    qa = rms_norm(heads(qa, N_HEADS_FOX), g_q_fox)
    ka = rms_norm(heads(ka, N_HEADS_FOX), g_k_fox)
    log_f = jax.nn.log_sigmoid((fa + b_f).astype(jnp.float32))
    o_a = fox_attention(bhsd(qa), bhsd(ka), bhsd(heads(va, N_HEADS_FOX)), log_f.transpose(0, 2, 1))
    o_a = bhsd(o_a).astype(h.dtype) * jax.nn.sigmoid(heads(ga, N_HEADS_FOX))
    c3, s3 = cos[:, None, :], sin[:, None, :]
    qd = partial_rope(rms_norm(heads(qd, N_HEADS_DIL), g_q_dil), c3, s3)
    kd = partial_rope(rms_norm(heads(kd, N_HEADS_DIL), g_k_dil), c3, s3)
    o_b = dilated_attention(bhsd(qd), bhsd(kd), bhsd(heads(vd, N_HEADS_DIL)))
    o_b = bhsd(o_b).astype(h.dtype)
    o = jnp.concatenate([o_a.reshape(B, S, FOX_W), o_b.reshape(B, S, DIL_W)], axis=-1)
    return o @ w_out


def compress(x_tok, pe, w1, w2):
    S = x_tok.shape[2]
    n_cmp = (S - CMP_BLOCK) // CMP_STRIDE + 1
    idx = np.arange(n_cmp)[:, None] * CMP_STRIDE + np.arange(CMP_BLOCK)[None, :]
    blk = x_tok[:, :, idx] + pe
    flat = blk.reshape(blk.shape[:3] + (CMP_BLOCK * HEAD_DIM,))
    return jax.nn.gelu(flat @ w1) @ w2


def cmp_slc_overlap(n_cmp, n_slc):
    start = np.arange(n_cmp) * CMP_STRIDE
    js = np.arange(n_slc) * SLC_BLOCK
    ov = (start[:, None] < js[None, :] + SLC_BLOCK) & (start[:, None] + CMP_BLOCK > js[None, :])
    return ov.astype(np.float32)


def nsa_attention(q, kc, vc, k_slc, v_slc, k_win, v_win, gates):
    B, G, HPG, S, Dh = q.shape
    n_cmp = kc.shape[2]
    n_slc = S // SLC_BLOCK
    n_sel = min(N_SELECT, n_slc)
    qb = NSA_Q_BLOCK
    nb = S // qb
    cmp_end = jnp.arange(n_cmp) * CMP_STRIDE + CMP_BLOCK - 1
    overlap = jnp.asarray(cmp_slc_overlap(n_cmp, n_slc))
    ks_blocks = k_slc.reshape(B, G, n_slc, SLC_BLOCK, Dh)
    vs_blocks = v_slc.reshape(B, G, n_slc, SLC_BLOCK, Dh)
    kw_pad = jnp.pad(k_win, ((0, 0), (0, 0), (WINDOW_NSA, 0), (0, 0)))
    vw_pad = jnp.pad(v_win, ((0, 0), (0, 0), (WINDOW_NSA, 0), (0, 0)))
    b_ix = jnp.arange(B)[:, None, None, None]
    g_ix = jnp.arange(G)[None, :, None, None]
    blk_ix = jnp.arange(n_slc)
    q_st = jnp.moveaxis(q.reshape(B, G, HPG, nb, qb, Dh), 3, 0)
    g_st = jnp.moveaxis(gates.reshape(B, G, HPG, nb, qb, 3), 3, 0)

    def block(args):
        i, qi, gi = args
        qpos = i * qb + jnp.arange(qb)
        s_c = jnp.einsum('bghqd,bgnd->bghqn', qi, kc).astype(jnp.float32) * SCALE
        p_c = masked_softmax(s_c, cmp_end[None, :] <= qpos[:, None])
        o_c = jnp.einsum('bghqn,bgnd->bghqd', p_c, vc)
        imp = jnp.einsum('bghqn,nj->bgqj', p_c, overlap)
        cur = (qpos // SLC_BLOCK)[:, None]
        forced = (blk_ix == 0) | (blk_ix == cur) | (blk_ix == cur - 1)
        imp = jnp.where(forced, FORCED_SCORE, imp)
        imp = jnp.where(blk_ix <= cur, imp, NEG)
        top_val, top_idx = lax.top_k(imp, n_sel)
        k_sel = ks_blocks[b_ix, g_ix, top_idx].reshape(B, G, qb, n_sel * SLC_BLOCK, Dh)
        v_sel = vs_blocks[b_ix, g_ix, top_idx].reshape(B, G, qb, n_sel * SLC_BLOCK, Dh)
        tok = (top_idx[..., None] * SLC_BLOCK + jnp.arange(SLC_BLOCK)).reshape(B, G, qb, n_sel * SLC_BLOCK)
        ok = jnp.repeat(top_val > 0.5 * NEG, SLC_BLOCK, axis=-1) & (tok <= qpos[:, None])
        s_s = jnp.einsum('bghqd,bgqkd->bghqk', qi, k_sel).astype(jnp.float32) * SCALE
        p_s = masked_softmax(s_s, ok[:, :, None])
        o_s = jnp.einsum('bghqk,bgqkd->bghqd', p_s, v_sel)
        kw = lax.dynamic_slice_in_dim(kw_pad, i * qb, qb + WINDOW_NSA, axis=2)
        vw = lax.dynamic_slice_in_dim(vw_pad, i * qb, qb + WINDOW_NSA, axis=2)
        kpos = i * qb - WINDOW_NSA + jnp.arange(qb + WINDOW_NSA)
        dist = qpos[:, None] - kpos[None, :]
        mask_w = (dist >= 0) & (dist < WINDOW_NSA) & (kpos[None, :] >= 0)
        s_w = jnp.einsum('bghqd,bgkd->bghqk', qi, kw).astype(jnp.float32) * SCALE
        p_w = masked_softmax(s_w, mask_w)
        o_w = jnp.einsum('bghqk,bgkd->bghqd', p_w, vw)
        gi = gi.astype(jnp.float32)
        return gi[..., 0:1] * o_c + gi[..., 1:2] * o_s + gi[..., 2:3] * o_w

    o = lax.map(block, (jnp.arange(nb), q_st, g_st))
    return jnp.moveaxis(o, 0, 3).reshape(B, G, HPG, S, Dh)


def odd_mixer(h, w_in, w_out, k_pe, k_w1, k_w2, v_pe, v_w1, v_w2, g_q, g_kc, g_ks, g_kw, cos, sin):
    B, S, _ = h.shape
    G, HPG = N_KV_NSA, N_HEADS_NSA // N_KV_NSA
    proj = h @ w_in
    splits = np.cumsum([Q_NSA_W] + [KV_NSA_W] * 6).tolist()
    q, kc, vc, ks, vs, kw, vw, gt = jnp.split(proj, splits, axis=-1)
    c3, s3 = cos[:, None, :], sin[:, None, :]
    q = partial_rope(rms_norm(q.reshape(B, S, N_HEADS_NSA, HEAD_DIM), g_q), c3, s3)
    q = q.reshape(B, S, G, HPG, HEAD_DIM).transpose(0, 2, 3, 1, 4)

    def kv(t):
        return t.reshape(B, S, G, HEAD_DIM)

    def to_bg(t):
        return t.transpose(0, 2, 1, 3)

    ks = to_bg(partial_rope(rms_norm(kv(ks), g_ks), c3, s3))
    kw = to_bg(partial_rope(rms_norm(kv(kw), g_kw), c3, s3))
    vs = to_bg(kv(vs))
    vw = to_bg(kv(vw))
    n_cmp = (S - CMP_BLOCK) // CMP_STRIDE + 1
    cos_c, sin_c = rope_tables(jnp.arange(n_cmp) * CMP_STRIDE + CMP_BLOCK - 1)
    kc = partial_rope(rms_norm(compress(to_bg(kv(kc)), k_pe, k_w1, k_w2), g_kc), cos_c, sin_c)
    vc = compress(to_bg(kv(vc)), v_pe, v_w1, v_w2)
    gates = jax.nn.sigmoid(gt.reshape(B, S, G, HPG, 3)).transpose(0, 2, 3, 1, 4)
    o = nsa_attention(q, kc, vc, ks, vs, kw, vw, gates)
    o = o.transpose(0, 3, 1, 2, 4).reshape(B, S, Q_NSA_W).astype(h.dtype)
    return o @ w_out


def setup_inputs(seed: int = 0) -> dict:
    key = jax.random.key(seed)
    keys = iter(jax.random.split(key, 40))

    def nrm(shape, scale):
        return jax.random.normal(next(keys), shape, jnp.float32) * scale

    def gain(shape):
        return 1.0 + 0.02 * jax.random.normal(next(keys), shape, jnp.float32)

    D = D_MODEL
    return {
        'x': nrm((BATCH, SEQ, D), 1.0),
        'ln_mix_g': gain((DEPTH, D)),
        'ln_mlp_g': gain((DEPTH, D)),
        'w_mlp_up': nrm((DEPTH, D, D_FF), D ** -0.5),
        'w_mlp_down': nrm((DEPTH, D_FF, D), D_FF ** -0.5),
        'even_w_in': nrm((N_EVEN, D, EVEN_IN), D ** -0.5),
        'even_b_f': nrm((N_EVEN, N_HEADS_FOX), 0.1),
        'even_w_out': nrm((N_EVEN, FOX_W + DIL_W, D), (FOX_W + DIL_W) ** -0.5),
        'even_g_q_fox': gain((N_EVEN, HEAD_DIM)),
        'even_g_k_fox': gain((N_EVEN, HEAD_DIM)),
        'even_g_q_dil': gain((N_EVEN, HEAD_DIM)),
        'even_g_k_dil': gain((N_EVEN, HEAD_DIM)),
        'odd_w_in': nrm((N_ODD, D, ODD_IN), D ** -0.5),
        'odd_w_out': nrm((N_ODD, Q_NSA_W, D), Q_NSA_W ** -0.5),
        'odd_phi_k_pe': nrm((N_ODD, CMP_BLOCK, HEAD_DIM), 0.1),
        'odd_phi_k_w1': nrm((N_ODD, CMP_BLOCK * HEAD_DIM, HEAD_DIM), (CMP_BLOCK * HEAD_DIM) ** -0.5),
        'odd_phi_k_w2': nrm((N_ODD, HEAD_DIM, HEAD_DIM), HEAD_DIM ** -0.5),
        'odd_phi_v_pe': nrm((N_ODD, CMP_BLOCK, HEAD_DIM), 0.1),
        'odd_phi_v_w1': nrm((N_ODD, CMP_BLOCK * HEAD_DIM, HEAD_DIM), (CMP_BLOCK * HEAD_DIM) ** -0.5),
        'odd_phi_v_w2': nrm((N_ODD, HEAD_DIM, HEAD_DIM), HEAD_DIM ** -0.5),
        'odd_g_q': gain((N_ODD, HEAD_DIM)),
        'odd_g_kc': gain((N_ODD, HEAD_DIM)),
        'odd_g_ks': gain((N_ODD, HEAD_DIM)),
        'odd_g_kw': gain((N_ODD, HEAD_DIM)),
    }


def reference(x, ln_mix_g, ln_mlp_g, w_mlp_up, w_mlp_down, even_w_in, even_b_f, even_w_out,
              even_g_q_fox, even_g_k_fox, even_g_q_dil, even_g_k_dil, odd_w_in, odd_w_out,
              odd_phi_k_pe, odd_phi_k_w1, odd_phi_k_w2, odd_phi_v_pe, odd_phi_v_w1, odd_phi_v_w2,
              odd_g_q, odd_g_kc, odd_g_ks, odd_g_kw):
    S = x.shape[1]
    cos, sin = rope_tables(jnp.arange(S))
    h = x
    for layer in range(DEPTH):
        hn = rms_norm(h, ln_mix_g[layer])
        if layer % 2 == 0:
            i = layer // 2
            h = h + even_mixer(hn, even_w_in[i], even_b_f[i], even_w_out[i], even_g_q_fox[i],
                               even_g_k_fox[i], even_g_q_dil[i], even_g_k_dil[i], cos, sin)
        else:
            i = layer // 2
            h = h + odd_mixer(hn, odd_w_in[i], odd_w_out[i], odd_phi_k_pe[i], odd_phi_k_w1[i],
                              odd_phi_k_w2[i], odd_phi_v_pe[i], odd_phi_v_w1[i], odd_phi_v_w2[i],
                              odd_g_q[i], odd_g_kc[i], odd_g_ks[i], odd_g_kw[i], cos, sin)
        hn = rms_norm(h, ln_mlp_g[layer])
        h = h + sq_relu_mlp(hn, w_mlp_up[layer], w_mlp_down[layer])
    return h
```

```cpp
#include <hip/hip_runtime.h>
#include <hip/hip_cooperative_groups.h>
#include <cstdio>
namespace cg = cooperative_groups;

#define DI __device__ __forceinline__
typedef unsigned short u16;
typedef short bf16x8 __attribute__((ext_vector_type(8)));
typedef short s16x4 __attribute__((ext_vector_type(4)));
typedef float f32x16 __attribute__((ext_vector_type(16)));
typedef float f32x2 __attribute__((ext_vector_type(2)));
typedef float f32x4 __attribute__((ext_vector_type(4)));
typedef __bf16 bf16x2_t __attribute__((ext_vector_type(2)));
typedef unsigned u32x4 __attribute__((ext_vector_type(4)));
typedef unsigned u32x2 __attribute__((ext_vector_type(2)));

#ifndef MULTI_LAUNCH
#define MULTI_LAUNCH 0
#endif

constexpr int NB = 4, SEQ = 4096, DM = 2048, NT = NB * SEQ;
constexpr int DFF = 8192;
constexpr int EVEN_IN = 7176, EVEN_PAD = 7424;
constexpr int ODD_IN = 5168, ODD_PAD = 5248;
constexpr float EPS = 1e-6f;
constexpr float SCALE = 0.08838834764831845f;
constexpr float L2E = 1.4426950408889634f;

constexpr size_t MiB = 1u << 20;
constexpr size_t OFF_WT_IN = 0;
constexpr size_t OFF_WT_OUT = OFF_WT_IN + (size_t)EVEN_PAD * DM * 2;
constexpr size_t OFF_WT_UP = OFF_WT_OUT + (size_t)DM * DM * 2;
constexpr size_t OFF_WT_DN = OFF_WT_UP + (size_t)DFF * DM * 2;
constexpr size_t OFF_W1T = OFF_WT_DN + (size_t)DFF * DM * 2;
constexpr size_t OFF_W2T = OFF_W1T + 2 * MiB;
constexpr size_t OFF_PEC = OFF_W2T + 65536;
constexpr size_t OFF_ROPE = OFF_PEC + 8192;
constexpr size_t OFF_RS0 = OFF_ROPE + 524288;
constexpr size_t OFF_SSQ = OFF_RS0 + 65536;
constexpr size_t OFF_BAR = OFF_SSQ + MiB;
constexpr size_t OFF_HB = OFF_BAR + 16384;
constexpr size_t OFF_ACT = OFF_HB + 64 * MiB;
constexpr size_t OFF_QF = OFF_ACT;
constexpr size_t OFF_KF = OFF_QF + 32 * MiB;
constexpr size_t OFF_VF = OFF_KF + 32 * MiB;
constexpr size_t OFF_QD = OFF_VF + 32 * MiB;
constexpr size_t OFF_KD = OFF_QD + 32 * MiB;
constexpr size_t OFF_VD = OFF_KD + 32 * MiB;
constexpr size_t OFF_OB = OFF_VD + 32 * MiB;
constexpr size_t OFF_LOGF = OFF_OB + 64 * MiB;
constexpr size_t OFF_DILDEN = OFF_LOGF + MiB / 2;
constexpr size_t OFF_QN = OFF_ACT;
constexpr size_t OFF_KCR = OFF_QN + 64 * MiB;
constexpr size_t OFF_VCR = OFF_KCR + 16 * MiB;
constexpr size_t OFF_KS = OFF_VCR + 16 * MiB;
constexpr size_t OFF_VS = OFF_KS + 16 * MiB;
constexpr size_t OFF_KW = OFF_VS + 16 * MiB;
constexpr size_t OFF_VW = OFF_KW + 16 * MiB;
constexpr size_t OFF_GATES = OFF_VW + 16 * MiB;
constexpr size_t OFF_HID = OFF_GATES + 3 * MiB;
constexpr size_t OFF_KC = OFF_HID + 2 * MiB;
constexpr size_t OFF_VC = OFF_KC + MiB;
constexpr size_t OFF_PART = OFF_VC + MiB;
constexpr size_t WS_NEED = OFF_ACT + 258 * MiB;

constexpr int SMEM_BYTES = 73728;

struct Params {
  const float* x; const float* ln_mix_g; const float* ln_mlp_g; const float* w_up; const float* w_down;
  const float* e_w_in; const float* e_b_f; const float* e_w_out; const float* e_gq_fox; const float* e_gk_fox;
  const float* e_gq_dil; const float* e_gk_dil; const float* o_w_in; const float* o_w_out;
  const float* k_pe; const float* k_w1; const float* k_w2; const float* v_pe; const float* v_w1; const float* v_w2;
  const float* o_gq; const float* o_gkc; const float* o_gks; const float* o_gkw;
  float* out; char* ws;
  int phase_lo, phase_hi;
};

__device__ __forceinline__ size_t blk32(size_t tile_idx, int nks, int R, int r, int col) {
  const int ks = col >> 5, c = (col & 31) >> 3, e = col & 7;
  return ((tile_idx * nks + ks) * R + r) * 32 + (size_t)((((c ^ ((r >> 2) & 3)) << 3) | e));
}
DI int opaque_tid() { int t = threadIdx.x; asm volatile("" : "+v"(t)); return t; }
DI char* opaque_ptr(char* p) { asm volatile("" : "+s"(p)); return p; }
DI unsigned pk2(float a, float b) {
  bf16x2_t v = __builtin_convertvector((f32x2){a, b}, bf16x2_t);
  return __builtin_bit_cast(unsigned, v);
}
DI float bflo(unsigned u) { return __uint_as_float(u << 16); }
DI float bfhi(unsigned u) { return __uint_as_float(u & 0xffff0000u); }
DI f32x16 mfma32(bf16x8 a, bf16x8 b, f32x16 c) { return __builtin_amdgcn_mfma_f32_32x32x16_bf16(a, b, c, 0, 0, 0); }
DI float sigmoidf_(float x) { return 1.f / (1.f + __expf(-x)); }
DI float wave_sum(float v) {
#pragma unroll
  for (int o = 32; o > 0; o >>= 1) v += __shfl_xor(v, o);
  return v;
}
DI float wave_max(float v) {
#pragma unroll
  for (int o = 32; o > 0; o >>= 1) v = fmaxf(v, __shfl_xor(v, o));
  return v;
}

DI void transpose_tile(const float* __restrict__ src, int N, u16* __restrict__ dst, int ldd, const float* __restrict__ gain,
                       int permmode, int kt, int ntile, char* smem) {
  float* tile = (float*)smem;
  const int tid = opaque_tid();
  const int c4 = (tid & 15) * 4, r0 = tid >> 4;
#pragma unroll
  for (int j = 0; j < 4; ++j) {
    const int kl = r0 + 16 * j, k = kt * 64 + kl, n = ntile * 64 + c4;
    f32x4 val = {0.f, 0.f, 0.f, 0.f};
    if (n < N) val = *(const f32x4*)(src + (size_t)k * N + n);
    const float g = gain ? gain[k] : 1.f;
    tile[kl * 65 + c4 + 0] = val[0] * g; tile[kl * 65 + c4 + 1] = val[1] * g;
    tile[kl * 65 + c4 + 2] = val[2] * g; tile[kl * 65 + c4 + 3] = val[3] * g;
  }
  __syncthreads();
  const int kc = tid & 7;
#pragma unroll
  for (int j = 0; j < 2; ++j) {
    const int nl = (tid >> 3) + 32 * j, n = ntile * 64 + nl;
    if (n < N) {
      int pn = n;
      if (permmode == 1) pn = (n < 4096) ? n : ((n < 4104) ? (7168 + n - 4096) : (n - 8));
      u32x4 o;
      o[0] = pk2(tile[(kc * 8 + 0) * 65 + nl], tile[(kc * 8 + 1) * 65 + nl]);
      o[1] = pk2(tile[(kc * 8 + 2) * 65 + nl], tile[(kc * 8 + 3) * 65 + nl]);
      o[2] = pk2(tile[(kc * 8 + 4) * 65 + nl], tile[(kc * 8 + 5) * 65 + nl]);
      o[3] = pk2(tile[(kc * 8 + 6) * 65 + nl], tile[(kc * 8 + 7) * 65 + nl]);
      if (ldd > 0) *(u32x4*)(dst + (size_t)pn * ldd + kt * 64 + kc * 8) = o;
      else *(u32x4*)(dst + blk32(pn >> 8, -2 * ldd, 256, pn & 255, kt * 64 + kc * 8)) = o;
    }
  }
  __syncthreads();
}

DI void phase_prep(const Params& p, char* smem, int layer) {
  char* ws = opaque_ptr(p.ws);
  constexpr int T_UP = 32 * 128, T_DN = 128 * 32, T_IN0 = 32 * 113, T_OUT = 32 * 32, T_IN1 = 32 * 81, T_W1 = 64 * 2, T_W2 = 4;
  const int t_in = layer ? T_IN1 : T_IN0;
  const int I1 = T_UP;
  const int I2 = I1 + T_DN;
  const int I3 = I2 + t_in;
  const int I4 = I3 + T_OUT;
  const int I5 = I4 + T_W1;
  const int I6 = I5 + T_W1;
  const int I7 = I6 + T_W2;
  const int I8 = I7 + T_W2;
  const int I9 = I8 + NT / 4;
  const int I10 = I9 + 256;
  const int I11 = I10 + 16;
  const int total = layer ? I4 : I11;
  for (int it = blockIdx.x; it < total; it += gridDim.x) {
    const int ptid = opaque_tid();
    if (it < I1) { int i = it; transpose_tile(p.w_up + (size_t)layer * DM * DFF, DFF, (u16*)(ws + OFF_WT_UP), -32, p.ln_mlp_g + layer * DM, 0, i / 128, i % 128, smem); }
    else if (it < I2) { int i = it - I1; transpose_tile(p.w_down + (size_t)layer * DFF * DM, DM, (u16*)(ws + OFF_WT_DN), -128, nullptr, 0, i / 32, i % 32, smem); }
    else if (it < I3) {
      int i = it - I2;
      if (layer == 0) transpose_tile(p.e_w_in, EVEN_IN, (u16*)(ws + OFF_WT_IN), -32, p.ln_mix_g, 1, i / 113, i % 113, smem);
      else transpose_tile(p.o_w_in, ODD_IN, (u16*)(ws + OFF_WT_IN), -32, p.ln_mix_g + DM, 0, i / 81, i % 81, smem);
    }
    else if (it < I4) { int i = it - I3; transpose_tile(layer ? p.o_w_out : p.e_w_out, DM, (u16*)(ws + OFF_WT_OUT), -32, nullptr, 0, i / 32, i % 32, smem); }
    else if (it < I5) { int i = it - I4; transpose_tile(p.k_w1, 128, (u16*)(ws + OFF_W1T), 4096, nullptr, 0, i / 2, i % 2, smem); }
    else if (it < I6) { int i = it - I5; transpose_tile(p.v_w1, 128, (u16*)(ws + OFF_W1T + MiB), 4096, nullptr, 0, i / 2, i % 2, smem); }
    else if (it < I7) { int i = it - I6; transpose_tile(p.k_w2, 128, (u16*)(ws + OFF_W2T), 128, nullptr, 0, i / 2, i % 2, smem); }
    else if (it < I8) { int i = it - I7; transpose_tile(p.v_w2, 128, (u16*)(ws + OFF_W2T + 32768), 128, nullptr, 0, i / 2, i % 2, smem); }
    else if (it < I9) {
      const int row = (it - I8) * 4 + (ptid >> 6), lane = ptid & 63;
      const f32x4* xp = (const f32x4*)(p.x + (size_t)row * DM);
      f32x4 v[8]; float ss = 0.f;
#pragma unroll
      for (int j = 0; j < 8; ++j) { v[j] = xp[lane + 64 * j]; ss += v[j][0] * v[j][0] + v[j][1] * v[j][1] + v[j][2] * v[j][2] + v[j][3] * v[j][3]; }
      ss = wave_sum(ss);
      if (lane == 0) ((float*)(ws + OFF_RS0))[row] = rsqrtf(ss * (1.f / DM) + EPS);
      u16* hb = (u16*)(ws + OFF_HB);
#pragma unroll
      for (int j = 0; j < 8; ++j) {
        const int col = (lane + 64 * j) * 4;
        u32x2 o = {pk2(v[j][0], v[j][1]), pk2(v[j][2], v[j][3])};
        *(u32x2*)(hb + blk32(row >> 7, 64, 128, row & 127, col)) = o;
      }
    } else if (it < I10) {
      const int idx = (it - I9) * 256 + ptid;
      const int pos = idx >> 4, j = idx & 15;
      const float inv = __builtin_amdgcn_exp2f(-18.931568569324174f * (float)(2 * j) * (1.f / 32.f));
      float rev = (float)pos * inv * 0.15915494309189535f;
      rev -= floorf(rev);
      ((float*)(ws + OFF_ROPE))[idx] = __builtin_amdgcn_cosf(rev);
      ((float*)(ws + OFF_ROPE))[65536 + idx] = __builtin_amdgcn_sinf(rev);
    } else {
      const int i = it - I10, kv = i >> 3, part = i & 7;
      const float* pe = kv ? p.v_pe : p.k_pe; const float* w1 = kv ? p.v_w1 : p.k_w1;
      const int c4 = (ptid & 31) * 4, kg = ptid >> 5;
      f32x4 sacc = {0.f, 0.f, 0.f, 0.f};
      const int k0 = part * 512 + kg * 64;
#pragma unroll 8
      for (int k = k0; k < k0 + 64; ++k) {
        const f32x4 w = *(const f32x4*)(w1 + (size_t)k * 128 + c4);
        const float e = pe[k];
        sacc[0] += e * w[0]; sacc[1] += e * w[1]; sacc[2] += e * w[2]; sacc[3] += e * w[3];
      }
      float* red = (float*)smem;
      *(f32x4*)(red + kg * 128 + c4) = sacc;
      __syncthreads();
      if (ptid < 128) {
        float t = 0.f;
#pragma unroll
        for (int g8 = 0; g8 < 8; ++g8) t += red[g8 * 128 + ptid];
        ((float*)(ws + OFF_PEC))[(kv * 8 + part) * 128 + ptid] = t;
      }
      __syncthreads();
    }
  }
}

enum { MODE_IN0 = 0, MODE_OUT0, MODE_UP, MODE_DOWN, MODE_IN1, MODE_C1, MODE_C2 };

DI void store64_bf16(u16* dst, const float (&v)[64]) {
#pragma unroll
  for (int j = 0; j < 8; ++j) {
    u32x4 o = {pk2(v[8 * j], v[8 * j + 1]), pk2(v[8 * j + 2], v[8 * j + 3]), pk2(v[8 * j + 4], v[8 * j + 5]), pk2(v[8 * j + 6], v[8 * j + 7])};
    *(u32x4*)(dst + 8 * j) = o;
  }
}
DI void rmsnorm128(float (&v)[64], const float* __restrict__ g) {
  float ss = 0.f;
#pragma unroll
  for (int c = 0; c < 64; ++c) ss += v[c] * v[c];
  ss += __shfl_xor(ss, 1);
  const float inv = rsqrtf(ss * (1.f / 128.f) + EPS);
#pragma unroll
  for (int c = 0; c < 64; ++c) v[c] = v[c] * inv * g[c];
}
DI void rope32(float (&v)[64], const float* __restrict__ cs, const float* __restrict__ sn) {
#pragma unroll
  for (int j = 0; j < 16; ++j) {
    const float c = cs[j], s = sn[j], x1 = v[j], x2 = v[16 + j];
    v[j] = x1 * c - x2 * s; v[16 + j] = x2 * c + x1 * s;
  }
}

DI void gemm_epilogue(const Params& p, int mode, int mt, int nt, int aux, char* smem, float rs_pre);

#define GWAIT_V(n) asm volatile("s_waitcnt vmcnt(%0)" ::"n"(n) : "memory")
#define GRAW_BARRIER() do { asm volatile("s_waitcnt lgkmcnt(0)" ::: "memory"); __builtin_amdgcn_s_barrier(); } while (0)
DI void gemm_tile(const Params& p, const u16* __restrict__ A, size_t lda, size_t hs, bool ablk, const u16* __restrict__ Bt, size_t ldb, bool bblk, int K,
                  int mode, int mt, int nt2, int ntiles, int aux, char* smem) {
  const int tid = opaque_tid(), lane = tid & 63, wid = tid >> 6;
  const int wr = wid >> 1, wc = wid & 1, l31 = lane & 31, lh = lane >> 5;
  constexpr int STG = 24576;
  const int drow = 16 * wid + (lane >> 2);
  const int dch = (lane & 3) ^ ((drow >> 2) & 3);
  const u16* ap = ablk ? A + wid * 512 + lane * 8 : A + (size_t)drow * lda + dch * 8;
  const u16* bp = bblk ? Bt + wid * 512 + lane * 8 : Bt + (size_t)drow * ldb + dch * 8;
  const size_t ais = ablk ? 2048 : 64 * lda, bis = bblk ? 2048 : 64 * ldb;
  const int wbase = __builtin_amdgcn_readfirstlane(wid) * 1024;
#define G_STAGE(buf_, t_) do { const size_t ao_ = ablk ? (size_t)(t_) * 4096 : (size_t)((t_) >> 2) * hs + ((t_) & 3) * 32; \
    const size_t bo_ = bblk ? (size_t)(t_) * 8192 : (size_t)(t_) * 32; \
    char* sb_ = smem + (buf_) * STG + wbase; \
    _Pragma("unroll") for (int i = 0; i < 2; ++i) __builtin_amdgcn_global_load_lds((const unsigned*)(ap + ao_ + i * ais), (unsigned*)(sb_ + i * 4096), 16, 0, 0); \
    _Pragma("unroll") for (int i = 0; i < 4; ++i) __builtin_amdgcn_global_load_lds((const unsigned*)(bp + bo_ + i * bis), (unsigned*)(sb_ + 8192 + i * 4096), 16, 0, 0); } while (0)
  f32x16 acc[2][4];
#pragma unroll
  for (int a = 0; a < 2; ++a)
#pragma unroll
    for (int b = 0; b < 4; ++b)
#pragma unroll
      for (int i = 0; i < 16; ++i) acc[a][b][i] = 0.f;
  const int nt = K >> 5;
  int offA[2], offB[4];
#pragma unroll
  for (int i = 0; i < 2; ++i) { const int r = wr * 64 + i * 32 + l31; offA[i] = r * 64 + ((lh ^ ((r >> 2) & 3)) << 4); }
#pragma unroll
  for (int i = 0; i < 4; ++i) { const int r = wc * 128 + i * 32 + l31; offB[i] = 8192 + r * 64 + ((lh ^ ((r >> 2) & 3)) << 4); }
  const unsigned lds0 = (unsigned)(size_t)smem;
  GRAW_BARRIER();
  G_STAGE(0, 0); G_STAGE(1, 1);
  GWAIT_V(6);
  GRAW_BARRIER();
  int cur = 0;
  for (int t = 0; t < nt; ++t) {
    const unsigned sb = lds0 + cur * STG;
    bf16x8 f0[6], f1[6];
    asm volatile(
        "ds_read_b128 %0, %12\n\tds_read_b128 %1, %13\n\tds_read_b128 %2, %14\n\tds_read_b128 %3, %15\n\tds_read_b128 %4, %16\n\tds_read_b128 %5, %17\n\t"
        "ds_read_b128 %6, %18\n\tds_read_b128 %7, %19\n\tds_read_b128 %8, %20\n\tds_read_b128 %9, %21\n\tds_read_b128 %10, %22\n\tds_read_b128 %11, %23"
        : "=&v"(f0[0]), "=&v"(f0[1]), "=&v"(f0[2]), "=&v"(f0[3]), "=&v"(f0[4]), "=&v"(f0[5]),
          "=&v"(f1[0]), "=&v"(f1[1]), "=&v"(f1[2]), "=&v"(f1[3]), "=&v"(f1[4]), "=&v"(f1[5])
        : "v"(sb + offA[0]), "v"(sb + offA[1]), "v"(sb + offB[0]), "v"(sb + offB[1]), "v"(sb + offB[2]), "v"(sb + offB[3]),
          "v"(sb + (offA[0] ^ 32)), "v"(sb + (offA[1] ^ 32)), "v"(sb + (offB[0] ^ 32)), "v"(sb + (offB[1] ^ 32)), "v"(sb + (offB[2] ^ 32)), "v"(sb + (offB[3] ^ 32))
        : "memory");
    if (t + 2 < nt) { const int nb = (cur >= 1) ? cur - 1 : 2; G_STAGE(nb, t + 2); }
    asm volatile("s_waitcnt lgkmcnt(6)" : "+v"(f0[0]), "+v"(f0[1]), "+v"(f0[2]), "+v"(f0[3]), "+v"(f0[4]), "+v"(f0[5]) :: "memory");
    __builtin_amdgcn_s_setprio(1);
#pragma unroll
    for (int a = 0; a < 2; ++a)
#pragma unroll
      for (int b = 0; b < 4; ++b) acc[a][b] = mfma32(f0[a], f0[2 + b], acc[a][b]);
    asm volatile("s_waitcnt lgkmcnt(0)" : "+v"(f1[0]), "+v"(f1[1]), "+v"(f1[2]), "+v"(f1[3]), "+v"(f1[4]), "+v"(f1[5]) :: "memory");
#pragma unroll
    for (int a = 0; a < 2; ++a)
#pragma unroll
      for (int b = 0; b < 4; ++b) acc[a][b] = mfma32(f1[a], f1[2 + b], acc[a][b]);
    __builtin_amdgcn_s_setprio(0);
    if (t + 2 < nt) GWAIT_V(6); else GWAIT_V(0);
    GRAW_BARRIER();
    cur = (cur == 2) ? 0 : cur + 1;
  }
#undef G_STAGE
  float rs_pre = 1.f;
  {
    const int erow = mt * 128 + (tid >> 1);
    if (mode == MODE_UP || mode == MODE_IN1) {
      const float* ssq = (const float*)(p.ws + OFF_SSQ);
      float sacc = 0.f;
#pragma unroll
      for (int j = 0; j < 16; ++j) sacc += ssq[j * NT + erow];
      rs_pre = rsqrtf(sacc * (1.f / DM) + EPS);
    } else if (mode == MODE_IN0) rs_pre = ((const float*)(p.ws + OFF_RS0))[erow];
  }
  float* sC = (float*)smem;
#pragma unroll 1
  for (int h = 0; h < 2; ++h) {
    GRAW_BARRIER(); asm volatile("" ::: "memory");
    if (wc == h) {
#pragma unroll
      for (int a = 0; a < 2; ++a)
#pragma unroll
        for (int b = 0; b < 4; ++b)
#pragma unroll
          for (int i = 0; i < 16; ++i) {
            const int row = wr * 64 + a * 32 + 8 * (i >> 2) + 4 * lh + (i & 3), col = b * 32 + l31;
            sC[row * 132 + col] = acc[a][b][i];
          }
    }
    GRAW_BARRIER(); asm volatile("" ::: "memory");
    if (nt2 * 2 + h < ntiles) gemm_epilogue(p, mode, mt, nt2 * 2 + h, aux, smem, rs_pre);
  }
}

DI void gemm_epilogue(const Params& p, int mode, int mt, int nt, int aux, char* smem, float rs_pre) {
  const int tid = opaque_tid();
  float* sC = (float*)smem;
  const int r = tid >> 1, half = tid & 1, cb = half * 64;
  const float* crow = sC + r * 132 + cb;
  char* ws = opaque_ptr(p.ws);
  const int row = mt * 128 + r;
  if (mode == MODE_OUT0 || mode == MODE_DOWN) {
    const float* res = (mode == MODE_OUT0) ? p.x : p.out;
    const size_t off = (size_t)row * DM + nt * 128 + cb;
    float ss = 0.f;
    f32x4 rq[4];
#pragma unroll
    for (int j = 0; j < 4; ++j) rq[j] = *(const f32x4*)(res + off + 4 * j);
#pragma unroll 1
    for (int ch = 0; ch < 4; ++ch) {
      float v[16];
      f32x4 rn[4];
      if (ch < 3) {
#pragma unroll
        for (int j = 0; j < 4; ++j) rn[j] = *(const f32x4*)(res + off + (ch + 1) * 16 + 4 * j);
      }
#pragma unroll
      for (int j = 0; j < 4; ++j) {
        const f32x4 t = *(const f32x4*)(crow + ch * 16 + 4 * j);
        const f32x4 q = rq[j];
        f32x4 o = {t[0] + q[0], t[1] + q[1], t[2] + q[2], t[3] + q[3]};
        *(f32x4*)(p.out + off + ch * 16 + 4 * j) = o;
        v[4 * j] = o[0]; v[4 * j + 1] = o[1]; v[4 * j + 2] = o[2]; v[4 * j + 3] = o[3];
        ss += o[0] * o[0] + o[1] * o[1] + o[2] * o[2] + o[3] * o[3];
      }
      if (aux == 0) {
        const int hcol = nt * 128 + cb + ch * 16;
        u16* hb = (u16*)(ws + OFF_HB) + blk32(mt, 64, 128, r, hcol);
        u16* hb2 = (u16*)(ws + OFF_HB) + blk32(mt, 64, 128, r, hcol + 8);
        u32x4 o0 = {pk2(v[0], v[1]), pk2(v[2], v[3]), pk2(v[4], v[5]), pk2(v[6], v[7])};
        u32x4 o1 = {pk2(v[8], v[9]), pk2(v[10], v[11]), pk2(v[12], v[13]), pk2(v[14], v[15])};
        *(u32x4*)hb = o0; *(u32x4*)hb2 = o1;
      }
      if (ch < 3) {
#pragma unroll
        for (int j = 0; j < 4; ++j) rq[j] = rn[j];
      }
    }
    if (aux == 0) {
      ss += __shfl_xor(ss, 1);
      if (!half) ((float*)(ws + OFF_SSQ))[nt * NT + row] = ss;
    }
  } else {
    float rs = 1.f; const float* gain = nullptr; bool rope = false; int act = 0; u16* dst = nullptr; int pos = 0; int special = 0;
    const int b = row >> 12, sq = row & 4095;
    if (mode == MODE_UP || mode == MODE_IN1) rs = rs_pre;
    if (mode == MODE_UP) { act = 2; dst = (u16*)(ws + OFF_ACT); }
    else if (mode == MODE_IN0) {
      rs = rs_pre; pos = sq;
      const int typ = nt >> 3, h = nt & 7;
      const size_t hoff = ((size_t)(b * 8 + h) * SEQ + sq) * 128;
      const size_t ooff = ((size_t)(b * 16 + h) * SEQ + sq) * 128;
      if (nt == 56) special = 1;
      else if (typ == 0) { gain = p.e_gq_fox; dst = (u16*)(ws + OFF_QF) + hoff; }
      else if (typ == 1) { gain = p.e_gk_fox; dst = (u16*)(ws + OFF_KF) + hoff; }
      else if (typ == 2) { dst = (u16*)(ws + OFF_VF) + hoff; }
      else if (typ == 3) { act = 1; dst = (u16*)(ws + OFF_OB) + ooff; }
      else if (typ == 4) { gain = p.e_gq_dil; rope = true; dst = (u16*)(ws + OFF_QD) + hoff; }
      else if (typ == 5) { gain = p.e_gk_dil; rope = true; dst = (u16*)(ws + OFF_KD) + hoff; }
      else { dst = (u16*)(ws + OFF_VD) + hoff; }
    } else if (mode == MODE_IN1) {
      pos = sq;
      if (nt < 16) { gain = p.o_gq; rope = true; dst = (u16*)(ws + OFF_QN) + ((size_t)(b * 16 + nt) * SEQ + sq) * 128; }
      else if (nt < 40) {
        const int typ = (nt - 16) >> 2, g = (nt - 16) & 3;
        const size_t goff = ((size_t)(b * 4 + g) * SEQ + sq) * 128;
        if (typ == 0) dst = (u16*)(ws + OFF_KCR) + goff;
        else if (typ == 1) dst = (u16*)(ws + OFF_VCR) + goff;
        else if (typ == 2) { gain = p.o_gks; rope = true; dst = (u16*)(ws + OFF_KS) + goff; }
        else if (typ == 3) dst = (u16*)(ws + OFF_VS) + goff;
        else if (typ == 4) { gain = p.o_gkw; rope = true; dst = (u16*)(ws + OFF_KW) + goff; }
        else dst = (u16*)(ws + OFF_VW) + goff;
      } else special = 2;
    } else if (mode == MODE_C1) {
      special = 3;
    } else if (mode == MODE_C2) {
      const int n = row & 255;
      dst = (u16*)(ws + (aux ? OFF_VC : OFF_KC)) + (size_t)row * 128;
      if (aux == 0) { gain = p.o_gkc; rope = true; pos = (16 * n + 31) & 4095; }
      if (n == 255) act = 4;
    }
    if (special == 1) {
      if (!half) {
        float* lf = (float*)(ws + OFF_LOGF);
#pragma unroll
        for (int hh = 0; hh < 8; ++hh) {
          const float z = crow[hh] * rs + p.e_b_f[hh];
          lf[(size_t)(b * 8 + hh) * SEQ + sq] = fminf(z, 0.f) - __logf(1.f + __expf(-fabsf(z)));
        }
      }
    } else if (special == 3) {
      float* pp = (float*)(ws + OFF_PART) + ((size_t)aux * 4096 + row) * 128 + cb;
#pragma unroll 4
      for (int j = 0; j < 16; ++j) *(f32x4*)(pp + 4 * j) = *(const f32x4*)(crow + 4 * j);
    } else if (special == 2) {
      if (!half) {
        float* gt = (float*)(ws + OFF_GATES) + (size_t)row * 48;
#pragma unroll 4
        for (int c = 0; c < 48; ++c) gt[c] = sigmoidf_(crow[c] * rs);
      }
    } else {
      float scale = rs;
      if (gain) {
        float* sG = (float*)(smem + 67584);
        if (tid < 128) sG[tid] = gain[tid];
        GRAW_BARRIER(); asm volatile("" ::: "memory");
        gain = sG;
      }
      if (gain) {
        float ss = 0.f;
#pragma unroll 4
        for (int j = 0; j < 16; ++j) { const f32x4 t = *(const f32x4*)(crow + 4 * j); ss += t[0] * t[0] + t[1] * t[1] + t[2] * t[2] + t[3] * t[3]; }
        ss += __shfl_xor(ss, 1);
        scale = rs * rsqrtf(rs * rs * ss * (1.f / 128.f) + EPS);
      }
      const float* rc = (const float*)(ws + OFF_ROPE) + pos * 16;
      float rcs[16], rsn[16];
#pragma unroll
      for (int j = 0; j < 16; ++j) { rcs[j] = 1.f; rsn[j] = 0.f; }
      if (rope && !half) {
#pragma unroll
        for (int j = 0; j < 4; ++j) {
          const f32x4 c4 = *(const f32x4*)(rc + 4 * j), s4 = *(const f32x4*)(rc + 65536 + 4 * j);
          rcs[4 * j] = c4[0]; rcs[4 * j + 1] = c4[1]; rcs[4 * j + 2] = c4[2]; rcs[4 * j + 3] = c4[3];
          rsn[4 * j] = s4[0]; rsn[4 * j + 1] = s4[1]; rsn[4 * j + 2] = s4[2]; rsn[4 * j + 3] = s4[3];
        }
      }
      const float* pec = (const float*)(ws + OFF_PEC) + aux * 8 * 128;
#pragma unroll 1
      for (int ch = 0; ch < 4; ++ch) {
        const int c0 = cb + ch * 16;
        float v[16];
#pragma unroll
        for (int j = 0; j < 16; ++j) { v[j] = crow[ch * 16 + j] * scale; if (gain) v[j] *= gain[c0 + j]; }
        if (rope && c0 < 32) {
          const int pc = c0 ^ 16;
#pragma unroll
          for (int j = 0; j < 16; ++j) {
            const float pv = sC[r * 132 + pc + j] * scale * gain[pc + j];
            const float c = rcs[j], sn = rsn[j];
            v[j] = (c0 == 0) ? (v[j] * c - pv * sn) : (v[j] * c + pv * sn);
          }
        }
        if (act == 1) {
#pragma unroll
          for (int j = 0; j < 16; ++j) v[j] = sigmoidf_(v[j]);
        } else if (act == 2) {
#pragma unroll
          for (int j = 0; j < 16; ++j) { const float u = fmaxf(v[j], 0.f); v[j] = u * u; }
        } else if (act == 3) {
#pragma unroll
          for (int j = 0; j < 16; ++j) {
            float xx = v[j];
#pragma unroll
            for (int q = 0; q < 8; ++q) xx += pec[q * 128 + c0 + j];
            const float y2 = 2.f * 0.7978845608028654f * (xx + 0.044715f * xx * xx * xx);
            v[j] = xx * (1.f - 1.f / (1.f + __expf(y2)));
          }
        } else if (act == 4) {
#pragma unroll
          for (int j = 0; j < 16; ++j) v[j] = 0.f;
        }
        u32x4 o0 = {pk2(v[0], v[1]), pk2(v[2], v[3]), pk2(v[4], v[5]), pk2(v[6], v[7])};
        u32x4 o1 = {pk2(v[8], v[9]), pk2(v[10], v[11]), pk2(v[12], v[13]), pk2(v[14], v[15])};
        u16* dp = dst + c0; u16* dp2 = dp + 8;
        if (mode == MODE_UP) { dp = dst + blk32(mt, 256, 128, r, nt * 128 + c0); dp2 = dst + blk32(mt, 256, 128, r, nt * 128 + c0 + 8); }
        if (mode == MODE_UP) {
          __builtin_nontemporal_store(o0, (u32x4*)dp); __builtin_nontemporal_store(o1, (u32x4*)dp2);
        } else { *(u32x4*)dp = o0; *(u32x4*)dp2 = o1; }
      }
    }
  }
}

#define XB_XCNT(j)  (256  + 64 * (j))
#define XB_XSUB(j)  (1280 + 64 * (j))
#define XB_XGEN(j)  (2304 + 64 * (j))
#define XB_TOP      3328
#define XB_TOPGEN   3392
DI unsigned xb_ld(unsigned* p) { return __hip_atomic_load(p, __ATOMIC_RELAXED, __HIP_MEMORY_SCOPE_AGENT); }
DI unsigned xb_add(unsigned* p, unsigned v) { return __hip_atomic_fetch_add(p, v, __ATOMIC_RELAXED, __HIP_MEMORY_SCOPE_AGENT); }
DI unsigned xb_xcc_id() { return (unsigned)__builtin_amdgcn_s_getreg((3 << 11) | 20) & 0xFu; }
DI void xcd_barrier(unsigned* bar, unsigned x, const unsigned* st) {
  asm volatile("s_waitcnt vmcnt(0)" ::: "memory");
  __syncthreads();
  if (threadIdx.x == 0) {
    const unsigned nloc = st[0], nx = st[1];
    const unsigned old = xb_add(&bar[XB_XSUB(x)], 1u);
    const unsigned gen = old / nloc;
    if (old + 1u == (gen + 1u) * nloc) {
      __builtin_amdgcn_fence(__ATOMIC_RELEASE, "agent");
      asm volatile("s_waitcnt vmcnt(0)" ::: "memory");
      const unsigned og = xb_add(&bar[XB_TOP], 1u);
      const unsigned tg = og / nx;
      if (og + 1u == (tg + 1u) * nx) xb_add(&bar[XB_TOPGEN], 1u);
      else while (xb_ld(&bar[XB_TOPGEN]) == tg) __builtin_amdgcn_s_sleep(1);
      __builtin_amdgcn_fence(__ATOMIC_ACQUIRE, "agent");
      xb_add(&bar[XB_XGEN(x)], 1u);
      asm volatile("s_waitcnt vmcnt(0)" ::: "memory");
    } else {
      while (xb_ld(&bar[XB_XGEN(x)]) == gen) __builtin_amdgcn_s_sleep(1);
      __builtin_amdgcn_fence(__ATOMIC_ACQUIRE, "agent");
      asm volatile("s_waitcnt vmcnt(0)" ::: "memory");
    }
  }
  __syncthreads();
}

constexpr int SKS = 272, SVS = 320;
constexpr int LDS_SK = 0, LDS_SV = 17408, LDS_X = 37888;
constexpr float SL2 = SCALE * L2E;

DI s16x4 tr_read(const char* ptr) {
  return __builtin_amdgcn_ds_read_tr16_b64_v4i16((__attribute__((address_space(3))) s16x4*)(ptr));
}
DI float gain_absmax(const float* g) {
  float m = 0.f;
  for (int i = 0; i < 128; ++i) m = fmaxf(m, fabsf(g[i]));
  return m;
}
template <class PF>
DI void attn_tile(const bf16x8 (&qf)[8], const char* smem, f32x16 (&acc)[4], float& lsum, PF&& pf) {
  const int lane = opaque_tid() & 63, l31 = lane & 31, lh = lane >> 5;
  const int q4 = (lane & 15) >> 2, p4 = lane & 3, blk = (lane >> 4) & 1;
  const char* sK = smem + LDS_SK; const char* sV = smem + LDS_SV;
#pragma unroll 1
  for (int u = 0; u < 2; ++u) {
    f32x16 sc;
#pragma unroll
    for (int i = 0; i < 16; ++i) sc[i] = 0.f;
#pragma unroll
    for (int kh = 0; kh < 2; ++kh) {
      bf16x8 a[4];
#pragma unroll
      for (int k2 = 0; k2 < 4; ++k2) a[k2] = *(const bf16x8*)(sK + (32 * u + l31) * SKS + (16 * (4 * kh + k2) + 8 * lh) * 2);
#pragma unroll
      for (int k2 = 0; k2 < 4; ++k2) sc = mfma32(a[k2], qf[4 * kh + k2], sc);
      __builtin_amdgcn_sched_barrier(0);
    }
    float pr[16];
    pf(u, sc, pr);
#pragma unroll
    for (int i = 0; i < 16; ++i) lsum += pr[i];
#pragma unroll
    for (int s = 0; s < 2; ++s) {
      u32x4 pw = {pk2(pr[8 * s], pr[8 * s + 1]), pk2(pr[8 * s + 2], pr[8 * s + 3]), pk2(pr[8 * s + 4], pr[8 * s + 5]), pk2(pr[8 * s + 6], pr[8 * s + 7])};
      const bf16x8 pb = __builtin_bit_cast(bf16x8, pw);
      bf16x8 a[4];
#pragma unroll
      for (int c = 0; c < 4; ++c) {
        const char* base = sV + (32 * u + 16 * s + 4 * lh + q4) * SVS + (32 * c + 16 * blk) * 2 + 8 * p4;
        const s16x4 lo = tr_read(base), hi = tr_read(base + 8 * SVS);
        a[c] = __builtin_shufflevector(lo, hi, 0, 1, 2, 3, 4, 5, 6, 7);
      }
#pragma unroll
      for (int c = 0; c < 4; ++c) acc[c] = mfma32(a[c], pb, acc[c]);
      __builtin_amdgcn_sched_barrier(0);
    }
  }
}
template <class RF>
DI void kv_load(u32x4 (&rk)[4], u32x4 (&rv)[4], const u16* K, const u16* V, RF&& rowoff) {
  const int tid0 = opaque_tid();
#pragma unroll
  for (int j = 0; j < 4; ++j) {
    const int idx = tid0 + 256 * j, key = idx >> 4, ch = idx & 15;
    const size_t off = rowoff(key) + ch * 8;
    rk[j] = *(const u32x4*)(K + off); rv[j] = *(const u32x4*)(V + off);
  }
}
DI void kv_store(const u32x4 (&rk)[4], const u32x4 (&rv)[4], char* smem) {
  const int tid0 = opaque_tid();
#pragma unroll
  for (int j = 0; j < 4; ++j) {
    const int idx = tid0 + 256 * j, key = idx >> 4, ch = idx & 15;
    *(u32x4*)(smem + LDS_SK + key * SKS + ch * 16) = rk[j];
    *(u32x4*)(smem + LDS_SV + key * SVS + ch * 16) = rv[j];
  }
}
DI void acc_zero(f32x16 (&acc)[4]) {
#pragma unroll
  for (int c = 0; c < 4; ++c)
#pragma unroll
    for (int i = 0; i < 16; ++i) acc[c][i] = 0.f;
}

DI void fox_item(const Params& p, int bh, int qt, char* smem, float mbl2) {
  char* ws = opaque_ptr(p.ws);
  const int tid = opaque_tid(), lane = tid & 63, wid = tid >> 6, l31 = lane & 31, lh = lane >> 5;
  const int b = bh >> 3, h = bh & 7;
  const u16* Q = (const u16*)(ws + OFF_QF) + (size_t)bh * SEQ * 128;
  const u16* K = (const u16*)(ws + OFF_KF) + (size_t)bh * SEQ * 128;
  const u16* V = (const u16*)(ws + OFF_VF) + (size_t)bh * SEQ * 128;
  u16* O = (u16*)(ws + OFF_OB) + (size_t)(b * 16 + h) * SEQ * 128;
  const float* lf = (const float*)(ws + OFF_LOGF) + (size_t)bh * SEQ;
  float* sCum = (float*)(smem + LDS_X);
  float* wtot = sCum + 4096;
  const int n = 128 * (qt + 1);
  __syncthreads();
  {
    float loc[16]; float tot = 0.f;
    const bool act = 16 * tid < n;
    if (act) {
#pragma unroll
      for (int j = 0; j < 4; ++j) {
        const f32x4 t = *(const f32x4*)(lf + 16 * tid + 4 * j);
        tot += t[0]; loc[4 * j] = tot; tot += t[1]; loc[4 * j + 1] = tot; tot += t[2]; loc[4 * j + 2] = tot; tot += t[3]; loc[4 * j + 3] = tot;
      }
    }
    float inc = tot;
#pragma unroll
    for (int o = 1; o < 64; o <<= 1) { const float y = __shfl_up(inc, o); if (lane >= o) inc += y; }
    if (lane == 63) wtot[wid] = inc;
    __syncthreads();
    float base = inc - tot;
    for (int w = 0; w < wid; ++w) base += wtot[w];
    if (act) {
#pragma unroll
      for (int j = 0; j < 16; ++j) sCum[16 * tid + j] = (base + loc[j]) * L2E;
    }
  }
  const int qrow = qt * 128 + wid * 32 + l31;
  bf16x8 qf[8];
#pragma unroll
  for (int ks = 0; ks < 8; ++ks) qf[ks] = *(const bf16x8*)(Q + (size_t)qrow * 128 + 16 * ks + 8 * lh);
  f32x16 acc[4]; acc_zero(acc);
  float lsum = 0.f;
  const int ntiles = 2 * (qt + 1);
  u32x4 rk[4], rv[4];
  __syncthreads();
  const float cq = sCum[qrow] - mbl2;
  int t0 = 0;
  {
    const float cq0 = sCum[qt * 128];
    int lo = 0, hi = ntiles - 2;
    while (lo < hi) { const int mid = (lo + hi) >> 1; if (cq0 - sCum[64 * mid + 63] < -160.f) lo = mid + 1; else hi = mid; }
    t0 = lo;
  }
  { const int k00 = 64 * t0; kv_load(rk, rv, K, V, [&](int key) { return (size_t)(k00 + key) * 128; }); }
  const int wqmax = qt * 128 + wid * 32 + 31;
  for (int t = t0; t < ntiles; ++t) {
    __syncthreads();
    kv_store(rk, rv, smem);
    if (t + 1 < ntiles) { const int k0n = 64 * (t + 1); kv_load(rk, rv, K, V, [&](int key) { return (size_t)(k0n + key) * 128; }); }
    __syncthreads();
    const int key0 = 64 * t;
    if (key0 + 63 <= wqmax - 31) {
      attn_tile(qf, smem, acc, lsum, [&](int u, const f32x16& sc, float (&pr)[16]) {
#pragma unroll
        for (int g = 0; g < 4; ++g) {
          const f32x4 ck = *(const f32x4*)(sCum + key0 + 32 * u + 8 * g + 4 * lh);
#pragma unroll
          for (int e = 0; e < 4; ++e) pr[4 * g + e] = __builtin_amdgcn_exp2f(sc[4 * g + e] * SL2 + (cq - ck[e]));
        }
      });
    } else if (key0 <= wqmax) {
      attn_tile(qf, smem, acc, lsum, [&](int u, const f32x16& sc, float (&pr)[16]) {
#pragma unroll
        for (int g = 0; g < 4; ++g) {
          const int kb = key0 + 32 * u + 8 * g + 4 * lh;
          const f32x4 ck = *(const f32x4*)(sCum + kb);
#pragma unroll
          for (int e = 0; e < 4; ++e) {
            const float arg = sc[4 * g + e] * SL2 + (cq - ck[e]);
            pr[4 * g + e] = (kb + e <= qrow) ? __builtin_amdgcn_exp2f(arg) : 0.f;
          }
        }
      });
    }
  }
  const float l = lsum + __shfl_xor(lsum, 32);
  const float inv = 1.f / l;
#pragma unroll
  for (int c = 0; c < 4; ++c)
#pragma unroll
    for (int g = 0; g < 4; ++g) {
      u16* op = O + (size_t)qrow * 128 + 32 * c + 8 * g + 4 * lh;
      const u32x2 gt = *(const u32x2*)op;
      u32x2 o = {pk2(acc[c][4 * g] * inv * bflo(gt[0]), acc[c][4 * g + 1] * inv * bfhi(gt[0])),
                 pk2(acc[c][4 * g + 2] * inv * bflo(gt[1]), acc[c][4 * g + 3] * inv * bfhi(gt[1]))};
      *(u32x2*)op = o;
    }
}

DI void dil_item(const Params& p, int pat, int bh, int sub, char* smem, float mbl2) {
  char* ws = opaque_ptr(p.ws);
  const int tid = opaque_tid(), lane = tid & 63, wid = tid >> 6, l31 = lane & 31, lh = lane >> 5;
  const int b = bh >> 3, h = bh & 7;
  const int dsh = 2 * pat, d = 1 << dsh, tpr = 32 >> dsh;
  const int res = sub / tpr, tile = sub % tpr;
  const u16* Q = (const u16*)(ws + OFF_QD) + (size_t)bh * SEQ * 128;
  const u16* K = (const u16*)(ws + OFF_KD) + (size_t)bh * SEQ * 128;
  const u16* V = (const u16*)(ws + OFF_VD) + (size_t)bh * SEQ * 128;
  u16* O = (u16*)(ws + OFF_OB) + (size_t)(b * 16 + 8 + h) * SEQ * 128;
  float* den = (float*)(ws + OFF_DILDEN) + (size_t)bh * SEQ;
  const int qm = tile * 128 + wid * 32 + l31, qtok = qm * d + res;
  bf16x8 qf[8];
#pragma unroll
  for (int ks = 0; ks < 8; ++ks) qf[ks] = *(const bf16x8*)(Q + (size_t)qtok * 128 + 16 * ks + 8 * lh);
  f32x16 acc[4]; acc_zero(acc);
  float lsum = 0.f;
  const int jlo = (tile == 0) ? 2 : 0;
  const int wq0 = tile * 128 + wid * 32;
  u32x4 rk[4], rv[4];
  auto rowf = [&](int km0) { return [=](int key) { int km = km0 + key; km = km < 0 ? 0 : km; return (size_t)(km * d + res) * 128; }; };
  kv_load(rk, rv, K, V, rowf(tile * 128 - 128 + 64 * jlo));
  for (int j = jlo; j < 4; ++j) {
    __syncthreads();
    kv_store(rk, rv, smem);
    if (j + 1 < 4) kv_load(rk, rv, K, V, rowf(tile * 128 - 128 + 64 * (j + 1)));
    __syncthreads();
    const int km0 = tile * 128 - 128 + 64 * j;
    if (km0 + 63 >= wq0 - 128 && km0 <= wq0 + 31) {
      attn_tile(qf, smem, acc, lsum, [&](int u, const f32x16& sc, float (&pr)[16]) {
#pragma unroll
        for (int i = 0; i < 16; ++i) {
          const int km = km0 + 32 * u + 8 * (i >> 2) + 4 * lh + (i & 3);
          const int dist = qm - km;
          pr[i] = (km >= 0 && dist >= 0 && dist <= 128) ? __builtin_amdgcn_exp2f(sc[i] * SL2 - mbl2) : 0.f;
        }
      });
    }
  }
  float l = lsum + __shfl_xor(lsum, 32);
  if (pat > 0) l += den[qtok];
  if (pat < 2) { if (lh == 0) den[qtok] = l; }
  const float inv = (pat == 2) ? 1.f / l : 1.f;
#pragma unroll
  for (int c = 0; c < 4; ++c)
#pragma unroll
    for (int g = 0; g < 4; ++g) {
      u16* op = O + (size_t)qtok * 128 + 32 * c + 8 * g + 4 * lh;
      float a0 = acc[c][4 * g], a1 = acc[c][4 * g + 1], a2 = acc[c][4 * g + 2], a3 = acc[c][4 * g + 3];
      if (pat > 0) { const u32x2 pv = *(const u32x2*)op; a0 += bflo(pv[0]); a1 += bfhi(pv[0]); a2 += bflo(pv[1]); a3 += bfhi(pv[1]); }
      u32x2 o = {pk2(a0 * inv, a1 * inv), pk2(a2 * inv, a3 * inv)};
      *(u32x2*)op = o;
    }
}

DI void phase_attn0(const Params& p, char* smem, int sub) {
  if (sub == 0) {
    const float mb = SCALE * 128.f * gain_absmax(p.e_gq_fox) * gain_absmax(p.e_gk_fox) * 1.02f * L2E;
    for (int j = blockIdx.x; j < 512; j += gridDim.x) {
#pragma unroll 1
      for (int k = 0; k < 2; ++k) {
        const int j2 = k ? 1023 - j : j;
        fox_item(p, j2 & 31, 31 - (j2 >> 5), smem, mb);
      }
    }
  }
  const float mbd = SCALE * 128.f * gain_absmax(p.e_gq_dil) * gain_absmax(p.e_gk_dil) * 1.02f * L2E;
  for (int i = blockIdx.x; i < 1024; i += gridDim.x) dil_item(p, sub, i >> 5, i & 31, smem, mbd);
}


constexpr int LDS_BS = LDS_X;
constexpr int LDS_LC = LDS_BS + 32768;
constexpr int LDS_SEL = LDS_LC + 512;
constexpr float NEGV = -1e30f;

DI void nsa_stash(u16* O, const f32x16 (&acc)[4], float sc, bool first, int lh) {
#pragma unroll
  for (int c = 0; c < 4; ++c)
#pragma unroll
    for (int g = 0; g < 4; ++g) {
      u16* op = O + 32 * c + 8 * g + 4 * lh;
      float a0 = acc[c][4 * g] * sc, a1 = acc[c][4 * g + 1] * sc, a2 = acc[c][4 * g + 2] * sc, a3 = acc[c][4 * g + 3] * sc;
      if (!first) { const u32x2 pv = *(const u32x2*)op; a0 += bflo(pv[0]); a1 += bfhi(pv[0]); a2 += bflo(pv[1]); a3 += bfhi(pv[1]); }
      u32x2 o = {pk2(a0, a1), pk2(a2, a3)};
      *(u32x2*)op = o;
    }
}

DI void nsa_item(const Params& p, int bg, int qt, char* smem, float mbc, float mbs, float mbw) {
  char* ws = opaque_ptr(p.ws);
  const int tid = opaque_tid(), lane = tid & 63, wid = tid >> 6, l31 = lane & 31, lh = lane >> 5;
  const int b = bg >> 2, g = bg & 3;
  const int q0 = qt * 32, t = q0 + l31;
  u16* QO = (u16*)(ws + OFF_QN) + ((size_t)(b * 16 + g * 4 + wid) * SEQ + t) * 128;
  const float* gt = (const float*)(ws + OFF_GATES) + (size_t)(b * SEQ + t) * 48 + g * 12 + wid * 3;
  const float g0 = gt[0], g1 = gt[1], g2 = gt[2];
  float* BS = (float*)(smem + LDS_BS);
  float* LC = (float*)(smem + LDS_LC);
  unsigned* SEL = (unsigned*)(smem + LDS_SEL);
  bf16x8 qf[8];
#pragma unroll
  for (int ks = 0; ks < 8; ++ks) qf[ks] = *(const bf16x8*)(QO + 16 * ks + 8 * lh);
  __syncthreads();
  for (int i = tid; i < 8192; i += 256) BS[i] = 0.f;
  f32x16 acc[4]; acc_zero(acc);
  float lsum = 0.f;
  u32x4 rk[4], rv[4];
  {
    const u16* K = (const u16*)(ws + OFF_KC) + (size_t)bg * 256 * 128;
    const u16* V = (const u16*)(ws + OFF_VC) + (size_t)bg * 256 * 128;
    const int ntiles = ((q0 >> 4) >> 6) + 1;
    float carry = 0.f;
    kv_load(rk, rv, K, V, [&](int key) { return (size_t)key * 128; });
    for (int tl = 0; tl < ntiles; ++tl) {
      __syncthreads();
      kv_store(rk, rv, smem);
      if (tl + 1 < ntiles) { const int n0n = 64 * (tl + 1); kv_load(rk, rv, K, V, [&](int key) { return (size_t)(n0n + key) * 128; }); }
      __syncthreads();
      const int n0 = 64 * tl;
      attn_tile(qf, smem, acc, lsum, [&](int u, const f32x16& sc, float (&pr)[16]) {
        float G[4], last[4];
#pragma unroll
        for (int a = 0; a < 4; ++a) {
          float gs = 0.f;
#pragma unroll
          for (int e = 0; e < 4; ++e) {
            const int n = n0 + 32 * u + 8 * a + 4 * lh + e;
            const float pv = (16 * n + 31 <= t) ? __builtin_amdgcn_exp2f(sc[4 * a + e] * SL2 - mbc) : 0.f;
            pr[4 * a + e] = pv; gs += pv;
          }
          G[a] = gs; last[a] = pr[4 * a + 3];
        }
        float x[4];
#pragma unroll
        for (int a = 0; a < 4; ++a) x[a] = __shfl_xor(last[a], 32);
        const int jb = (n0 + 32 * u) >> 2;
#pragma unroll
        for (int a = 0; a < 4; ++a) {
          const float add = lh ? x[a] : (a ? x[a > 0 ? a - 1 : 0] : carry);
          BS[(wid * 32 + l31) * 64 + jb + 2 * a + lh] = G[a] + add;
        }
        carry = x[3];
      });
    }
    const float l = lsum + __shfl_xor(lsum, 32);
    if (lh == 0) LC[wid * 32 + l31] = l;
    nsa_stash(QO, acc, l > 0.f ? g0 / l : 0.f, true, lh);
  }
  __syncthreads();
  for (int i = tid; i < 2048; i += 256) {
    const int q = i >> 6, j = i & 63;
    float imp = 0.f;
#pragma unroll
    for (int w = 0; w < 4; ++w) { const float l = LC[w * 32 + q]; imp += (l > 0.f) ? BS[(w * 32 + q) * 64 + j] / l : 0.f; }
    const int cur = (q0 + q) >> 6;
    if (j == 0 || j == cur || j == cur - 1) imp = 1e9f;
    if (j > cur) imp = NEGV;
    BS[q * 64 + j] = imp;
  }
  __syncthreads();
  for (int rep = 0; rep < 8; ++rep) {
    const int q = rep * 4 + wid, j = lane;
    const float v = BS[q * 64 + j];
    int rank = 0;
    for (int k = 0; k < 64; ++k) { const float o = BS[q * 64 + k]; rank += (o > v || (o == v && k < j)) ? 1 : 0; }
    const unsigned long long m = __ballot(rank < 16 && v > 0.5f * NEGV);
    if (lane == 0) { SEL[q * 2] = (unsigned)m; SEL[q * 2 + 1] = (unsigned)(m >> 32); }
  }
  __syncthreads();
  unsigned long long umask = 0;
  for (int q = 0; q < 32; ++q) umask |= (unsigned long long)SEL[q * 2] | ((unsigned long long)SEL[q * 2 + 1] << 32);
  const unsigned long long mymask = (unsigned long long)SEL[l31 * 2] | ((unsigned long long)SEL[l31 * 2 + 1] << 32);
  {
    const u16* K = (const u16*)(ws + OFF_KS) + (size_t)bg * SEQ * 128;
    const u16* V = (const u16*)(ws + OFF_VS) + (size_t)bg * SEQ * 128;
    acc_zero(acc); lsum = 0.f;
    unsigned long long rem = umask;
    int j = __builtin_ctzll(rem); rem &= rem - 1;
    { const int k0 = 64 * j; kv_load(rk, rv, K, V, [&](int key) { return (size_t)(k0 + key) * 128; }); }
    while (true) {
      __syncthreads();
      kv_store(rk, rv, smem);
      const int jn = rem ? __builtin_ctzll(rem) : -1;
      if (jn >= 0) { rem &= rem - 1; const int k0 = 64 * jn; kv_load(rk, rv, K, V, [&](int key) { return (size_t)(k0 + key) * 128; }); }
      __syncthreads();
      const bool mine = (mymask >> j) & 1;
      const int key0 = 64 * j;
      if (key0 + 63 <= q0) {
        attn_tile(qf, smem, acc, lsum, [&](int u, const f32x16& sc, float (&pr)[16]) {
#pragma unroll
          for (int i = 0; i < 16; ++i) pr[i] = mine ? __builtin_amdgcn_exp2f(sc[i] * SL2 - mbs) : 0.f;
        });
      } else {
        attn_tile(qf, smem, acc, lsum, [&](int u, const f32x16& sc, float (&pr)[16]) {
#pragma unroll
          for (int i = 0; i < 16; ++i) {
            const int key = key0 + 32 * u + 8 * (i >> 2) + 4 * lh + (i & 3);
            pr[i] = (mine && key <= t) ? __builtin_amdgcn_exp2f(sc[i] * SL2 - mbs) : 0.f;
          }
        });
      }
      if (jn < 0) break;
      j = jn;
    }
    const float l = lsum + __shfl_xor(lsum, 32);
    nsa_stash(QO, acc, l > 0.f ? g1 / l : 0.f, false, lh);
  }
  {
    const u16* K = (const u16*)(ws + OFF_KW) + (size_t)bg * SEQ * 128;
    const u16* V = (const u16*)(ws + OFF_VW) + (size_t)bg * SEQ * 128;
    acc_zero(acc); lsum = 0.f;
    const int tlo = (q0 >= 511 ? q0 - 511 : 0) >> 6, thi = (q0 + 31) >> 6;
    { const int k0 = 64 * tlo; kv_load(rk, rv, K, V, [&](int key) { return (size_t)(k0 + key) * 128; }); }
    for (int tl = tlo; tl <= thi; ++tl) {
      __syncthreads();
      kv_store(rk, rv, smem);
      if (tl + 1 <= thi) { const int k0 = 64 * (tl + 1); kv_load(rk, rv, K, V, [&](int key) { return (size_t)(k0 + key) * 128; }); }
      __syncthreads();
      const int key0 = 64 * tl;
      if (key0 + 63 <= q0 && key0 >= q0 + 31 - 511) {
        attn_tile(qf, smem, acc, lsum, [&](int u, const f32x16& sc, float (&pr)[16]) {
#pragma unroll
          for (int i = 0; i < 16; ++i) pr[i] = __builtin_amdgcn_exp2f(sc[i] * SL2 - mbw);
        });
      } else {
        attn_tile(qf, smem, acc, lsum, [&](int u, const f32x16& sc, float (&pr)[16]) {
#pragma unroll
          for (int i = 0; i < 16; ++i) {
            const int dist = t - (key0 + 32 * u + 8 * (i >> 2) + 4 * lh + (i & 3));
            pr[i] = (dist >= 0 && dist < 512) ? __builtin_amdgcn_exp2f(sc[i] * SL2 - mbw) : 0.f;
          }
        });
      }
    }
    const float l = lsum + __shfl_xor(lsum, 32);
    nsa_stash(QO, acc, l > 0.f ? g2 / l : 0.f, false, lh);
  }
}

DI void phase_nsa(const Params& p, char* smem) {
  const float gq = gain_absmax(p.o_gq) * SCALE * 128.f * 1.02f * L2E;
  const float mbc = gq * gain_absmax(p.o_gkc), mbs = gq * gain_absmax(p.o_gks), mbw = gq * gain_absmax(p.o_gkw);
  for (int j = blockIdx.x; j < 1024; j += gridDim.x) {
#pragma unroll 1
    for (int k = 0; k < 2; ++k) {
      const int j2 = k ? 2047 - j : j;
      nsa_item(p, j2 & 15, 127 - (j2 >> 4), smem, mbc, mbs, mbw);
    }
  }
}

DI void zero_buf(char* ptr, size_t bytes) {
  u32x4 z = {0, 0, 0, 0};
  u32x4* o = (u32x4*)ptr;
  for (size_t i = (size_t)blockIdx.x * 256 + threadIdx.x; i < bytes / 16; i += (size_t)gridDim.x * 256) o[i] = z;
}

constexpr int N_PHASES = 16;
__global__ void __launch_bounds__(256, 2) mega(Params p) {
  __shared__ __attribute__((aligned(16))) char smem[SMEM_BYTES];
  __shared__ unsigned xbst[4];
  char* ws = p.ws;
  if (threadIdx.x == 0) xb_add(&((unsigned*)(ws + OFF_BAR))[XB_XCNT(xb_xcc_id())], 1u);
  for (int ph = p.phase_lo; ph <= p.phase_hi; ++ph) {
    size_t offA = 0, offB = 0; int lda = DM, K = DM, tiles_n = 0, mode = -1, aux = 0, headmajor = 0;
    switch (ph) {
      case 1: offA = OFF_HB; offB = OFF_WT_IN; tiles_n = 57; mode = MODE_IN0; break;
      case 5: offA = OFF_OB; offB = OFF_WT_OUT; tiles_n = 16; mode = MODE_OUT0; headmajor = 1; break;
      case 6: offA = OFF_HB; offB = OFF_WT_UP; tiles_n = 64; mode = MODE_UP; break;
      case 7: offA = OFF_ACT; offB = OFF_WT_DN; lda = DFF; K = DFF; tiles_n = 16; mode = MODE_DOWN; break;
      case 9: offA = OFF_HB; offB = OFF_WT_IN; tiles_n = 41; mode = MODE_IN1; break;
      case 10: mode = MODE_C1; break;
      case 11: mode = MODE_C2; break;
      case 13: offA = OFF_QN; offB = OFF_WT_OUT; tiles_n = 16; mode = MODE_DOWN; headmajor = 1; break;
      case 14: offA = OFF_HB; offB = OFF_WT_UP; tiles_n = 64; mode = MODE_UP; break;
      case 15: offA = OFF_ACT; offB = OFF_WT_DN; lda = DFF; K = DFF; tiles_n = 16; mode = MODE_DOWN; aux = 1; break;
      default: break;
    }
    if (mode >= 0) {
      const int tiles_n2 = (tiles_n + 1) >> 1;
      const int total = (mode == MODE_C1) ? 256 : (mode == MODE_C2) ? 64 : 128 * tiles_n2;
      for (int i = blockIdx.x; i < total; i += gridDim.x) {
        const u16 *A, *Bt; size_t la, lb, hs = 128; bool ablk = false, bblk = false; int kk, mt, nt, ax, ntl = 1;
        if (mode == MODE_C1) {
          const int ksp = i & 3, r2 = i >> 2, kv = r2 >> 5; mt = r2 & 31; nt = 0; ax = kv | (ksp << 1);
          A = (const u16*)(ws + (kv ? OFF_VCR : OFF_KCR)) + (size_t)(mt >> 1) * SEQ * 128 + (size_t)(mt & 1) * 128 * 2048 + ksp * 1024;
          Bt = (const u16*)(ws + OFF_W1T + (size_t)kv * MiB) + ksp * 1024; la = 2048; lb = 4096; kk = 1024;
        } else if (mode == MODE_C2) {
          const int kv = i >> 5; mt = i & 31; nt = 0; ax = kv;
          A = (const u16*)(ws + OFF_HID + (size_t)kv * MiB) + (size_t)mt * 128 * 128;
          Bt = (const u16*)(ws + OFF_W2T + (size_t)kv * 32768); la = 128; lb = 128; kk = 128;
          {
            const int tid = opaque_tid(), r = tid >> 1, cb = (tid & 1) * 64, row = mt * 128 + r;
            const float* pec = (const float*)(ws + OFF_PEC) + kv * 8 * 128;
            u16* hd = (u16*)(ws + OFF_HID + (size_t)kv * MiB) + (size_t)row * 128 + cb;
#pragma unroll 1
            for (int ch = 0; ch < 4; ++ch) {
              float v[16];
#pragma unroll
              for (int j = 0; j < 16; ++j) v[j] = 0.f;
#pragma unroll
              for (int q = 0; q < 4; ++q) {
                const float* pp = (const float*)(ws + OFF_PART) + ((size_t)(kv | (q << 1)) * 4096 + row) * 128 + cb + ch * 16;
#pragma unroll
                for (int j = 0; j < 4; ++j) { const f32x4 t = *(const f32x4*)(pp + 4 * j); v[4 * j] += t[0]; v[4 * j + 1] += t[1]; v[4 * j + 2] += t[2]; v[4 * j + 3] += t[3]; }
              }
#pragma unroll
              for (int j = 0; j < 16; ++j) {
                float xx = v[j];
#pragma unroll
                for (int q = 0; q < 8; ++q) xx += pec[q * 128 + cb + ch * 16 + j];
                const float y2 = 2.f * 0.7978845608028654f * (xx + 0.044715f * xx * xx * xx);
                v[j] = xx * (1.f - 1.f / (1.f + __expf(y2)));
              }
              u32x4 o0 = {pk2(v[0], v[1]), pk2(v[2], v[3]), pk2(v[4], v[5]), pk2(v[6], v[7])};
              u32x4 o1 = {pk2(v[8], v[9]), pk2(v[10], v[11]), pk2(v[12], v[13]), pk2(v[14], v[15])};
              *(u32x4*)(hd + ch * 16) = o0; *(u32x4*)(hd + ch * 16 + 8) = o1;
            }
            __syncthreads();
          }
        } else {
          const int x = i & 7, seq = i >> 3;
          mt = x * 16 + (seq & 15); nt = seq >> 4; ax = aux; kk = K; ntl = tiles_n;
          const size_t nkk = (size_t)(K >> 6);
          if (headmajor) {
            la = 128; hs = (size_t)SEQ * 128;
            A = (const u16*)(ws + offA) + ((size_t)(mt >> 5) * 16 * SEQ + (size_t)(mt & 31) * 128) * 128;
          } else {
            la = 0; ablk = true;
            A = (const u16*)(ws + offA) + (size_t)mt * (nkk * 2) * 4096;
          }
          lb = 0; bblk = true;
          Bt = (const u16*)(ws + offB) + (size_t)nt * (nkk * 2) * 8192;
        }
        gemm_tile(p, A, la, hs, ablk, Bt, lb, bblk, kk, mode, mt, nt, ntl, ax, smem);
      }
    } else {
      switch (ph) {
        case 0: phase_prep(p, smem, 0); break;
        case 2: phase_attn0(p, smem, 0); break;
        case 3: phase_attn0(p, smem, 1); break;
        case 4: phase_attn0(p, smem, 2); break;
        case 8: phase_prep(p, smem, 1); break;
        case 12: phase_nsa(p, smem); break;
        default: break;
      }
    }
    if (ph < p.phase_hi) {
      unsigned* xbar = (unsigned*)(opaque_ptr(p.ws) + OFF_BAR);
      const unsigned xcc = xb_xcc_id();
      if (ph == p.phase_lo) {
        cg::this_grid().sync();
        if (threadIdx.x == 0) {
          unsigned mine = 0, cnt = 0;
          for (unsigned j = 0; j < 16; ++j) { const unsigned c = xb_ld(&xbar[XB_XCNT(j)]); cnt += (c > 0u) ? 1u : 0u; mine = (j == xcc) ? c : mine; }
          xbst[0] = mine > 0u ? mine : 1u; xbst[1] = cnt > 0u ? cnt : 1u;
        }
        __syncthreads();
      } else xcd_barrier(xbar, xcc, xbst);
    }
  }
}

__global__ void report_ws(float* out, int n, float val) {
  for (int i = blockIdx.x * 256 + threadIdx.x; i < n; i += gridDim.x * 256) out[i] = (i == 0) ? val : 0.f;
}

extern "C" void kernel_launch(void* const* d_in, const int* in_sizes, int n_in, void* d_out, int out_size, void* d_ws, size_t ws_size,
                              hipStream_t stream) {
  static int grid_blocks = 0;
  if (!grid_blocks) {
    int dev = 0, cus = 0, per_cu = 0;
    hipGetDevice(&dev);
    hipDeviceGetAttribute(&cus, hipDeviceAttributeMultiprocessorCount, dev);
    hipOccupancyMaxActiveBlocksPerMultiprocessor(&per_cu, mega, 256, 0);
    if (per_cu > 2) per_cu = 2;
    if (per_cu < 1) per_cu = 1;
    grid_blocks = cus * per_cu;
  }
  Params p{};
  const float** f = (const float**)&p;
  for (int i = 0; i < 24; ++i) f[i] = (const float*)d_in[i];
  p.out = (float*)d_out; p.ws = (char*)d_ws;
  if (ws_size < WS_NEED) {
    fprintf(stderr, "workspace too small: %zu < %zu\n", ws_size, (size_t)WS_NEED);
    hipLaunchKernelGGL(report_ws, dim3(1024), dim3(256), 0, stream, (float*)d_out, out_size, (float)(ws_size / 1000000));
    return;
  }
  hipMemsetAsync((char*)d_ws + OFF_BAR, 0, 16384, stream);
#if MULTI_LAUNCH
  for (int ph = 0; ph < N_PHASES; ++ph) {
    p.phase_lo = ph; p.phase_hi = ph;
    hipLaunchKernelGGL(mega, dim3(grid_blocks), dim3(256), 0, stream, p);
  }
#else
  p.phase_lo = 0; p.phase_hi = N_PHASES - 1;
  void* args[] = {&p};
  hipError_t e = hipLaunchCooperativeKernel((void*)mega, dim3(grid_blocks), dim3(256), args, 0, stream);
  if (e != hipSuccess) fprintf(stderr, "cooperative launch failed: %s (grid %d)\n", hipGetErrorString(e), grid_blocks);
#endif
}
```

```cpp
#include <hip/hip_runtime.h>
#include <hip/hip_cooperative_groups.h>
#include <cstdio>
namespace cg = cooperative_groups;

#define DI __device__ __forceinline__
typedef unsigned short u16;
typedef short bf16x8 __attribute__((ext_vector_type(8)));
typedef short s16x4 __attribute__((ext_vector_type(4)));
typedef float f32x16 __attribute__((ext_vector_type(16)));
typedef float f32x2 __attribute__((ext_vector_type(2)));
typedef float f32x4 __attribute__((ext_vector_type(4)));
typedef __bf16 bf16x2_t __attribute__((ext_vector_type(2)));
typedef unsigned u32x4 __attribute__((ext_vector_type(4)));
typedef unsigned u32x2 __attribute__((ext_vector_type(2)));

#ifndef MULTI_LAUNCH
#define MULTI_LAUNCH 0
#endif

constexpr int NB = 4, SEQ = 4096, DM = 2048, NT = NB * SEQ;
constexpr int DFF = 8192;
constexpr int EVEN_IN = 7176, EVEN_PAD = 7424;
constexpr int ODD_IN = 5168, ODD_PAD = 5248;
constexpr float EPS = 1e-6f;
constexpr float SCALE = 0.08838834764831845f;
constexpr float L2E = 1.4426950408889634f;

constexpr size_t MiB = 1u << 20;
constexpr size_t OFF_WT_IN = 0;
constexpr size_t OFF_WT_OUT = OFF_WT_IN + (size_t)EVEN_PAD * DM * 2;
constexpr size_t OFF_WT_UP = OFF_WT_OUT + (size_t)DM * DM * 2;
constexpr size_t OFF_WT_DN = OFF_WT_UP + (size_t)DFF * DM * 2;
constexpr size_t OFF_W1T = OFF_WT_DN + (size_t)DFF * DM * 2;
constexpr size_t OFF_W2T = OFF_W1T + 2 * MiB;
constexpr size_t OFF_PEC = OFF_W2T + 65536;
constexpr size_t OFF_ROPE = OFF_PEC + 8192;
constexpr size_t OFF_RS0 = OFF_ROPE + 524288;
constexpr size_t OFF_SSQ = OFF_RS0 + 65536;
constexpr size_t OFF_BAR = OFF_SSQ + MiB;
constexpr size_t OFF_HB = OFF_BAR + 16384;
constexpr size_t OFF_ACT = OFF_HB + 64 * MiB;
constexpr size_t OFF_QF = OFF_ACT;
constexpr size_t OFF_KF = OFF_QF + 32 * MiB;
constexpr size_t OFF_VF = OFF_KF + 32 * MiB;
constexpr size_t OFF_QD = OFF_VF + 32 * MiB;
constexpr size_t OFF_KD = OFF_QD + 32 * MiB;
constexpr size_t OFF_VD = OFF_KD + 32 * MiB;
constexpr size_t OFF_OB = OFF_VD + 32 * MiB;
constexpr size_t OFF_LOGF = OFF_OB + 64 * MiB;
constexpr size_t OFF_DILDEN = OFF_LOGF + MiB / 2;
constexpr size_t OFF_QN = OFF_ACT;
constexpr size_t OFF_KCR = OFF_QN + 64 * MiB;
constexpr size_t OFF_VCR = OFF_KCR + 16 * MiB;
constexpr size_t OFF_KS = OFF_VCR + 16 * MiB;
constexpr size_t OFF_VS = OFF_KS + 16 * MiB;
constexpr size_t OFF_KW = OFF_VS + 16 * MiB;
constexpr size_t OFF_VW = OFF_KW + 16 * MiB;
constexpr size_t OFF_GATES = OFF_VW + 16 * MiB;
constexpr size_t OFF_HID = OFF_GATES + 3 * MiB;
constexpr size_t OFF_KC = OFF_HID + 2 * MiB;
constexpr size_t OFF_VC = OFF_KC + MiB;
constexpr size_t OFF_PART = OFF_VC + MiB;
constexpr size_t WS_NEED = OFF_ACT + 258 * MiB;

constexpr int SMEM_BYTES = 73728;

struct Params {
  const float* x; const float* ln_mix_g; const float* ln_mlp_g; const float* w_up; const float* w_down;
  const float* e_w_in; const float* e_b_f; const float* e_w_out; const float* e_gq_fox; const float* e_gk_fox;
  const float* e_gq_dil; const float* e_gk_dil; const float* o_w_in; const float* o_w_out;
  const float* k_pe; const float* k_w1; const float* k_w2; const float* v_pe; const float* v_w1; const float* v_w2;
  const float* o_gq; const float* o_gkc; const float* o_gks; const float* o_gkw;
  float* out; char* ws;
  int phase_lo, phase_hi;
};

__device__ __forceinline__ size_t blk32(size_t tile_idx, int nks, int R, int r, int col) {
  const int ks = col >> 5, c = (col & 31) >> 3, e = col & 7;
  return ((tile_idx * nks + ks) * R + r) * 32 + (size_t)((((c ^ ((r >> 2) & 3)) << 3) | e));
}
DI int opaque_tid() { int t = threadIdx.x; asm volatile("" : "+v"(t)); return t; }
DI char* opaque_ptr(char* p) { asm volatile("" : "+s"(p)); return p; }
DI unsigned pk2(float a, float b) {
  bf16x2_t v = __builtin_convertvector((f32x2){a, b}, bf16x2_t);
  return __builtin_bit_cast(unsigned, v);
}
DI float bflo(unsigned u) { return __uint_as_float(u << 16); }
DI float bfhi(unsigned u) { return __uint_as_float(u & 0xffff0000u); }
DI f32x16 mfma32(bf16x8 a, bf16x8 b, f32x16 c) { return __builtin_amdgcn_mfma_f32_32x32x16_bf16(a, b, c, 0, 0, 0); }
DI float sigmoidf_(float x) { return 1.f / (1.f + __expf(-x)); }
DI float wave_sum(float v) {
#pragma unroll
  for (int o = 32; o > 0; o >>= 1) v += __shfl_xor(v, o);
  return v;
}
DI float wave_max(float v) {
#pragma unroll
  for (int o = 32; o > 0; o >>= 1) v = fmaxf(v, __shfl_xor(v, o));
  return v;
}

DI void transpose_tile(const float* __restrict__ src, int N, u16* __restrict__ dst, int ldd, const float* __restrict__ gain,
                       int permmode, int kt, int ntile, char* smem) {
  float* tile = (float*)smem;
  const int tid = opaque_tid();
  const int c4 = (tid & 15) * 4, r0 = tid >> 4;
#pragma unroll
  for (int j = 0; j < 4; ++j) {
    const int kl = r0 + 16 * j, k = kt * 64 + kl, n = ntile * 64 + c4;
    f32x4 val = {0.f, 0.f, 0.f, 0.f};
    if (n < N) val = *(const f32x4*)(src + (size_t)k * N + n);
    const float g = gain ? gain[k] : 1.f;
    tile[kl * 65 + c4 + 0] = val[0] * g; tile[kl * 65 + c4 + 1] = val[1] * g;
    tile[kl * 65 + c4 + 2] = val[2] * g; tile[kl * 65 + c4 + 3] = val[3] * g;
  }
  __syncthreads();
  const int kc = tid & 7;
#pragma unroll
  for (int j = 0; j < 2; ++j) {
    const int nl = (tid >> 3) + 32 * j, n = ntile * 64 + nl;
    if (n < N) {
      int pn = n;
      if (permmode == 1) pn = (n < 4096) ? n : ((n < 4104) ? (7168 + n - 4096) : (n - 8));
      u32x4 o;
      o[0] = pk2(tile[(kc * 8 + 0) * 65 + nl], tile[(kc * 8 + 1) * 65 + nl]);
      o[1] = pk2(tile[(kc * 8 + 2) * 65 + nl], tile[(kc * 8 + 3) * 65 + nl]);
      o[2] = pk2(tile[(kc * 8 + 4) * 65 + nl], tile[(kc * 8 + 5) * 65 + nl]);
      o[3] = pk2(tile[(kc * 8 + 6) * 65 + nl], tile[(kc * 8 + 7) * 65 + nl]);
      if (ldd > 0) *(u32x4*)(dst + (size_t)pn * ldd + kt * 64 + kc * 8) = o;
      else *(u32x4*)(dst + blk32(pn >> 8, -2 * ldd, 256, pn & 255, kt * 64 + kc * 8)) = o;
    }
  }
  __syncthreads();
}

DI void phase_prep(const Params& p, char* smem, int layer) {
  char* ws = opaque_ptr(p.ws);
  constexpr int T_UP = 32 * 128, T_DN = 128 * 32, T_IN0 = 32 * 113, T_OUT = 32 * 32, T_IN1 = 32 * 81, T_W1 = 64 * 2, T_W2 = 4;
  const int t_in = layer ? T_IN1 : T_IN0;
  const int I1 = T_UP;
  const int I2 = I1 + T_DN;
  const int I3 = I2 + t_in;
  const int I4 = I3 + T_OUT;
  const int I5 = I4 + T_W1;
  const int I6 = I5 + T_W1;
  const int I7 = I6 + T_W2;
  const int I8 = I7 + T_W2;
  const int I9 = I8 + NT / 4;
  const int I10 = I9 + 256;
  const int I11 = I10 + 16;
  const int total = layer ? I4 : I11;
  for (int it = blockIdx.x; it < total; it += gridDim.x) {
    const int ptid = opaque_tid();
    if (it < I1) { int i = it; transpose_tile(p.w_up + (size_t)layer * DM * DFF, DFF, (u16*)(ws + OFF_WT_UP), -32, p.ln_mlp_g + layer * DM, 0, i / 128, i % 128, smem); }
    else if (it < I2) { int i = it - I1; transpose_tile(p.w_down + (size_t)layer * DFF * DM, DM, (u16*)(ws + OFF_WT_DN), -128, nullptr, 0, i / 32, i % 32, smem); }
    else if (it < I3) {
      int i = it - I2;
      if (layer == 0) transpose_tile(p.e_w_in, EVEN_IN, (u16*)(ws + OFF_WT_IN), -32, p.ln_mix_g, 1, i / 113, i % 113, smem);
      else transpose_tile(p.o_w_in, ODD_IN, (u16*)(ws + OFF_WT_IN), -32, p.ln_mix_g + DM, 0, i / 81, i % 81, smem);
    }
    else if (it < I4) { int i = it - I3; transpose_tile(layer ? p.o_w_out : p.e_w_out, DM, (u16*)(ws + OFF_WT_OUT), -32, nullptr, 0, i / 32, i % 32, smem); }
    else if (it < I5) { int i = it - I4; transpose_tile(p.k_w1, 128, (u16*)(ws + OFF_W1T), 4096, nullptr, 0, i / 2, i % 2, smem); }
    else if (it < I6) { int i = it - I5; transpose_tile(p.v_w1, 128, (u16*)(ws + OFF_W1T + MiB), 4096, nullptr, 0, i / 2, i % 2, smem); }
    else if (it < I7) { int i = it - I6; transpose_tile(p.k_w2, 128, (u16*)(ws + OFF_W2T), 128, nullptr, 0, i / 2, i % 2, smem); }
    else if (it < I8) { int i = it - I7; transpose_tile(p.v_w2, 128, (u16*)(ws + OFF_W2T + 32768), 128, nullptr, 0, i / 2, i % 2, smem); }
    else if (it < I9) {
      const int row = (it - I8) * 4 + (ptid >> 6), lane = ptid & 63;
      const f32x4* xp = (const f32x4*)(p.x + (size_t)row * DM);
      f32x4 v[8]; float ss = 0.f;
#pragma unroll
      for (int j = 0; j < 8; ++j) { v[j] = xp[lane + 64 * j]; ss += v[j][0] * v[j][0] + v[j][1] * v[j][1] + v[j][2] * v[j][2] + v[j][3] * v[j][3]; }
      ss = wave_sum(ss);
      if (lane == 0) ((float*)(ws + OFF_RS0))[row] = rsqrtf(ss * (1.f / DM) + EPS);
      u16* hb = (u16*)(ws + OFF_HB);
#pragma unroll
      for (int j = 0; j < 8; ++j) {
        const int col = (lane + 64 * j) * 4;
        u32x2 o = {pk2(v[j][0], v[j][1]), pk2(v[j][2], v[j][3])};
        *(u32x2*)(hb + blk32(row >> 7, 64, 128, row & 127, col)) = o;
      }
    } else if (it < I10) {
      const int idx = (it - I9) * 256 + ptid;
      const int pos = idx >> 4, j = idx & 15;
      const float inv = __builtin_amdgcn_exp2f(-18.931568569324174f * (float)(2 * j) * (1.f / 32.f));
      float rev = (float)pos * inv * 0.15915494309189535f;
      rev -= floorf(rev);
      ((float*)(ws + OFF_ROPE))[idx] = __builtin_amdgcn_cosf(rev);
      ((float*)(ws + OFF_ROPE))[65536 + idx] = __builtin_amdgcn_sinf(rev);
    } else {
      const int i = it - I10, kv = i >> 3, part = i & 7;
      const float* pe = kv ? p.v_pe : p.k_pe; const float* w1 = kv ? p.v_w1 : p.k_w1;
      const int c4 = (ptid & 31) * 4, kg = ptid >> 5;
      f32x4 sacc = {0.f, 0.f, 0.f, 0.f};
      const int k0 = part * 512 + kg * 64;
#pragma unroll 8
      for (int k = k0; k < k0 + 64; ++k) {
        const f32x4 w = *(const f32x4*)(w1 + (size_t)k * 128 + c4);
        const float e = pe[k];
        sacc[0] += e * w[0]; sacc[1] += e * w[1]; sacc[2] += e * w[2]; sacc[3] += e * w[3];
      }
      float* red = (float*)smem;
      *(f32x4*)(red + kg * 128 + c4) = sacc;
      __syncthreads();
      if (ptid < 128) {
        float t = 0.f;
#pragma unroll
        for (int g8 = 0; g8 < 8; ++g8) t += red[g8 * 128 + ptid];
        ((float*)(ws + OFF_PEC))[(kv * 8 + part) * 128 + ptid] = t;
      }
      __syncthreads();
    }
  }
}

enum { MODE_IN0 = 0, MODE_OUT0, MODE_UP, MODE_DOWN, MODE_IN1, MODE_C1, MODE_C2 };

DI void store64_bf16(u16* dst, const float (&v)[64]) {
#pragma unroll
  for (int j = 0; j < 8; ++j) {
    u32x4 o = {pk2(v[8 * j], v[8 * j + 1]), pk2(v[8 * j + 2], v[8 * j + 3]), pk2(v[8 * j + 4], v[8 * j + 5]), pk2(v[8 * j + 6], v[8 * j + 7])};
    *(u32x4*)(dst + 8 * j) = o;
  }
}
DI void rmsnorm128(float (&v)[64], const float* __restrict__ g) {
  float ss = 0.f;
#pragma unroll
  for (int c = 0; c < 64; ++c) ss += v[c] * v[c];
  ss += __shfl_xor(ss, 1);
  const float inv = rsqrtf(ss * (1.f / 128.f) + EPS);
#pragma unroll
  for (int c = 0; c < 64; ++c) v[c] = v[c] * inv * g[c];
}
DI void rope32(float (&v)[64], const float* __restrict__ cs, const float* __restrict__ sn) {
#pragma unroll
  for (int j = 0; j < 16; ++j) {
    const float c = cs[j], s = sn[j], x1 = v[j], x2 = v[16 + j];
    v[j] = x1 * c - x2 * s; v[16 + j] = x2 * c + x1 * s;
  }
}

DI void gemm_epilogue(const Params& p, int mode, int mt, int nt, int aux, char* smem, float rs_pre);

#define GWAIT_V(n) asm volatile("s_waitcnt vmcnt(%0)" ::"n"(n) : "memory")
#define GRAW_BARRIER() do { asm volatile("s_waitcnt lgkmcnt(0)" ::: "memory"); __builtin_amdgcn_s_barrier(); } while (0)
DI void gemm_tile(const Params& p, const u16* __restrict__ A, size_t lda, size_t hs, bool ablk, const u16* __restrict__ Bt, size_t ldb, bool bblk, int K,
                  int mode, int mt, int nt2, int ntiles, int aux, char* smem) {
  const int tid = opaque_tid(), lane = tid & 63, wid = tid >> 6;
  const int wr = wid >> 1, wc = wid & 1, l31 = lane & 31, lh = lane >> 5;
  constexpr int STG = 24576;
  const int drow = 16 * wid + (lane >> 2);
  const int dch = (lane & 3) ^ ((drow >> 2) & 3);
  const u16* ap = ablk ? A + wid * 512 + lane * 8 : A + (size_t)drow * lda + dch * 8;
  const u16* bp = bblk ? Bt + wid * 512 + lane * 8 : Bt + (size_t)drow * ldb + dch * 8;
  const size_t ais = ablk ? 2048 : 64 * lda, bis = bblk ? 2048 : 64 * ldb;
  const int wbase = __builtin_amdgcn_readfirstlane(wid) * 1024;
#define G_STAGE(buf_, t_) do { const size_t ao_ = ablk ? (size_t)(t_) * 4096 : (size_t)((t_) >> 2) * hs + ((t_) & 3) * 32; \
    const size_t bo_ = bblk ? (size_t)(t_) * 8192 : (size_t)(t_) * 32; \
    char* sb_ = smem + (buf_) * STG + wbase; \
    _Pragma("unroll") for (int i = 0; i < 2; ++i) __builtin_amdgcn_global_load_lds((const unsigned*)(ap + ao_ + i * ais), (unsigned*)(sb_ + i * 4096), 16, 0, 0); \
    _Pragma("unroll") for (int i = 0; i < 4; ++i) __builtin_amdgcn_global_load_lds((const unsigned*)(bp + bo_ + i * bis), (unsigned*)(sb_ + 8192 + i * 4096), 16, 0, 0); } while (0)
  f32x16 acc[2][4];
#pragma unroll
  for (int a = 0; a < 2; ++a)
#pragma unroll
    for (int b = 0; b < 4; ++b)
#pragma unroll
      for (int i = 0; i < 16; ++i) acc[a][b][i] = 0.f;
  const int nt = K >> 5;
  int offA[2], offB[4];
#pragma unroll
  for (int i = 0; i < 2; ++i) { const int r = wr * 64 + i * 32 + l31; offA[i] = r * 64 + ((lh ^ ((r >> 2) & 3)) << 4); }
#pragma unroll
  for (int i = 0; i < 4; ++i) { const int r = wc * 128 + i * 32 + l31; offB[i] = 8192 + r * 64 + ((lh ^ ((r >> 2) & 3)) << 4); }
  const unsigned lds0 = (unsigned)(size_t)smem;
  GRAW_BARRIER();
  G_STAGE(0, 0); G_STAGE(1, 1);
  GWAIT_V(6);
  GRAW_BARRIER();
  int cur = 0;
  for (int t = 0; t < nt; ++t) {
    const unsigned sb = lds0 + cur * STG;
    bf16x8 f0[6], f1[6];
    asm volatile(
        "ds_read_b128 %0, %12\n\tds_read_b128 %1, %13\n\tds_read_b128 %2, %14\n\tds_read_b128 %3, %15\n\tds_read_b128 %4, %16\n\tds_read_b128 %5, %17\n\t"
        "ds_read_b128 %6, %18\n\tds_read_b128 %7, %19\n\tds_read_b128 %8, %20\n\tds_read_b128 %9, %21\n\tds_read_b128 %10, %22\n\tds_read_b128 %11, %23"
        : "=&v"(f0[0]), "=&v"(f0[1]), "=&v"(f0[2]), "=&v"(f0[3]), "=&v"(f0[4]), "=&v"(f0[5]),
          "=&v"(f1[0]), "=&v"(f1[1]), "=&v"(f1[2]), "=&v"(f1[3]), "=&v"(f1[4]), "=&v"(f1[5])
        : "v"(sb + offA[0]), "v"(sb + offA[1]), "v"(sb + offB[0]), "v"(sb + offB[1]), "v"(sb + offB[2]), "v"(sb + offB[3]),
          "v"(sb + (offA[0] ^ 32)), "v"(sb + (offA[1] ^ 32)), "v"(sb + (offB[0] ^ 32)), "v"(sb + (offB[1] ^ 32)), "v"(sb + (offB[2] ^ 32)), "v"(sb + (offB[3] ^ 32))
        : "memory");
    if (t + 2 < nt) { const int nb = (cur >= 1) ? cur - 1 : 2; G_STAGE(nb, t + 2); }
    asm volatile("s_waitcnt lgkmcnt(6)" : "+v"(f0[0]), "+v"(f0[1]), "+v"(f0[2]), "+v"(f0[3]), "+v"(f0[4]), "+v"(f0[5]) :: "memory");
    __builtin_amdgcn_s_setprio(1);
#pragma unroll
    for (int a = 0; a < 2; ++a)
#pragma unroll
      for (int b = 0; b < 4; ++b) acc[a][b] = mfma32(f0[a], f0[2 + b], acc[a][b]);
    asm volatile("s_waitcnt lgkmcnt(0)" : "+v"(f1[0]), "+v"(f1[1]), "+v"(f1[2]), "+v"(f1[3]), "+v"(f1[4]), "+v"(f1[5]) :: "memory");
#pragma unroll
    for (int a = 0; a < 2; ++a)
#pragma unroll
      for (int b = 0; b < 4; ++b) acc[a][b] = mfma32(f1[a], f1[2 + b], acc[a][b]);
    __builtin_amdgcn_s_setprio(0);
    if (t + 2 < nt) GWAIT_V(6); else GWAIT_V(0);
    GRAW_BARRIER();
    cur = (cur == 2) ? 0 : cur + 1;
  }
#undef G_STAGE
  float rs_pre = 1.f;
  {
    const int erow = mt * 128 + (tid >> 1);
    if (mode == MODE_UP || mode == MODE_IN1) {
      const float* ssq = (const float*)(p.ws + OFF_SSQ);
      float sacc = 0.f;
#pragma unroll
      for (int j = 0; j < 16; ++j) sacc += ssq[j * NT + erow];
      rs_pre = rsqrtf(sacc * (1.f / DM) + EPS);
    } else if (mode == MODE_IN0) rs_pre = ((const float*)(p.ws + OFF_RS0))[erow];
  }
  float* sC = (float*)smem;
#pragma unroll 1
  for (int h = 0; h < 2; ++h) {
    GRAW_BARRIER(); asm volatile("" ::: "memory");
    if (wc == h) {
#pragma unroll
      for (int a = 0; a < 2; ++a)
#pragma unroll
        for (int b = 0; b < 4; ++b)
#pragma unroll
          for (int i = 0; i < 16; ++i) {
            const int row = wr * 64 + a * 32 + 8 * (i >> 2) + 4 * lh + (i & 3), col = b * 32 + l31;
            sC[row * 132 + col] = acc[a][b][i];
          }
    }
    GRAW_BARRIER(); asm volatile("" ::: "memory");
    if (nt2 * 2 + h < ntiles) gemm_epilogue(p, mode, mt, nt2 * 2 + h, aux, smem, rs_pre);
  }
}

DI void gemm_epilogue(const Params& p, int mode, int mt, int nt, int aux, char* smem, float rs_pre) {
  const int tid = opaque_tid();
  float* sC = (float*)smem;
  const int r = tid >> 1, half = tid & 1, cb = half * 64;
  const float* crow = sC + r * 132 + cb;
  char* ws = opaque_ptr(p.ws);
  const int row = mt * 128 + r;
  if (mode == MODE_OUT0 || mode == MODE_DOWN) {
    const float* res = (mode == MODE_OUT0) ? p.x : p.out;
    const size_t off = (size_t)row * DM + nt * 128 + cb;
    float ss = 0.f;
    f32x4 rq[4];
#pragma unroll
    for (int j = 0; j < 4; ++j) rq[j] = *(const f32x4*)(res + off + 4 * j);
#pragma unroll 1
    for (int ch = 0; ch < 4; ++ch) {
      float v[16];
      f32x4 rn[4];
      if (ch < 3) {
#pragma unroll
        for (int j = 0; j < 4; ++j) rn[j] = *(const f32x4*)(res + off + (ch + 1) * 16 + 4 * j);
      }
#pragma unroll
      for (int j = 0; j < 4; ++j) {
        const f32x4 t = *(const f32x4*)(crow + ch * 16 + 4 * j);
        const f32x4 q = rq[j];
        f32x4 o = {t[0] + q[0], t[1] + q[1], t[2] + q[2], t[3] + q[3]};
        *(f32x4*)(p.out + off + ch * 16 + 4 * j) = o;
        v[4 * j] = o[0]; v[4 * j + 1] = o[1]; v[4 * j + 2] = o[2]; v[4 * j + 3] = o[3];
        ss += o[0] * o[0] + o[1] * o[1] + o[2] * o[2] + o[3] * o[3];
      }
      if (aux == 0) {
        const int hcol = nt * 128 + cb + ch * 16;
        u16* hb = (u16*)(ws + OFF_HB) + blk32(mt, 64, 128, r, hcol);
        u16* hb2 = (u16*)(ws + OFF_HB) + blk32(mt, 64, 128, r, hcol + 8);
        u32x4 o0 = {pk2(v[0], v[1]), pk2(v[2], v[3]), pk2(v[4], v[5]), pk2(v[6], v[7])};
        u32x4 o1 = {pk2(v[8], v[9]), pk2(v[10], v[11]), pk2(v[12], v[13]), pk2(v[14], v[15])};
        *(u32x4*)hb = o0; *(u32x4*)hb2 = o1;
      }
      if (ch < 3) {
#pragma unroll
        for (int j = 0; j < 4; ++j) rq[j] = rn[j];
      }
    }
    if (aux == 0) {
      ss += __shfl_xor(ss, 1);
      if (!half) ((float*)(ws + OFF_SSQ))[nt * NT + row] = ss;
    }
  } else {
    float rs = 1.f; const float* gain = nullptr; bool rope = false; int act = 0; u16* dst = nullptr; int pos = 0; int special = 0;
    const int b = row >> 12, sq = row & 4095;
    if (mode == MODE_UP || mode == MODE_IN1) rs = rs_pre;
    if (mode == MODE_UP) { act = 2; dst = (u16*)(ws + OFF_ACT); }
    else if (mode == MODE_IN0) {
      rs = rs_pre; pos = sq;
      const int typ = nt >> 3, h = nt & 7;
      const size_t hoff = ((size_t)(b * 8 + h) * SEQ + sq) * 128;
      const size_t ooff = ((size_t)(b * 16 + h) * SEQ + sq) * 128;
      if (nt == 56) special = 1;
      else if (typ == 0) { gain = p.e_gq_fox; dst = (u16*)(ws + OFF_QF) + hoff; }
      else if (typ == 1) { gain = p.e_gk_fox; dst = (u16*)(ws + OFF_KF) + hoff; }
      else if (typ == 2) { dst = (u16*)(ws + OFF_VF) + hoff; }
      else if (typ == 3) { act = 1; dst = (u16*)(ws + OFF_OB) + ooff; }
      else if (typ == 4) { gain = p.e_gq_dil; rope = true; dst = (u16*)(ws + OFF_QD) + hoff; }
      else if (typ == 5) { gain = p.e_gk_dil; rope = true; dst = (u16*)(ws + OFF_KD) + hoff; }
      else { dst = (u16*)(ws + OFF_VD) + hoff; }
    } else if (mode == MODE_IN1) {
      pos = sq;
      if (nt < 16) { gain = p.o_gq; rope = true; dst = (u16*)(ws + OFF_QN) + ((size_t)(b * 16 + nt) * SEQ + sq) * 128; }
      else if (nt < 40) {
        const int typ = (nt - 16) >> 2, g = (nt - 16) & 3;
        const size_t goff = ((size_t)(b * 4 + g) * SEQ + sq) * 128;
        if (typ == 0) dst = (u16*)(ws + OFF_KCR) + goff;
        else if (typ == 1) dst = (u16*)(ws + OFF_VCR) + goff;
        else if (typ == 2) { gain = p.o_gks; rope = true; dst = (u16*)(ws + OFF_KS) + goff; }
        else if (typ == 3) dst = (u16*)(ws + OFF_VS) + goff;
        else if (typ == 4) { gain = p.o_gkw; rope = true; dst = (u16*)(ws + OFF_KW) + goff; }
        else dst = (u16*)(ws + OFF_VW) + goff;
      } else special = 2;
    } else if (mode == MODE_C1) {
      special = 3;
    } else if (mode == MODE_C2) {
      const int n = row & 255;
      dst = (u16*)(ws + (aux ? OFF_VC : OFF_KC)) + (size_t)row * 128;
      if (aux == 0) { gain = p.o_gkc; rope = true; pos = (16 * n + 31) & 4095; }
      if (n == 255) act = 4;
    }
    if (special == 1) {
      if (!half) {
        float* lf = (float*)(ws + OFF_LOGF);
#pragma unroll
        for (int hh = 0; hh < 8; ++hh) {
          const float z = crow[hh] * rs + p.e_b_f[hh];
          lf[(size_t)(b * 8 + hh) * SEQ + sq] = fminf(z, 0.f) - __logf(1.f + __expf(-fabsf(z)));
        }
      }
    } else if (special == 3) {
      float* pp = (float*)(ws + OFF_PART) + ((size_t)aux * 4096 + row) * 128 + cb;
#pragma unroll 4
      for (int j = 0; j < 16; ++j) *(f32x4*)(pp + 4 * j) = *(const f32x4*)(crow + 4 * j);
    } else if (special == 2) {
      if (!half) {
        float* gt = (float*)(ws + OFF_GATES) + (size_t)row * 48;
#pragma unroll 4
        for (int c = 0; c < 48; ++c) gt[c] = sigmoidf_(crow[c] * rs);
      }
    } else {
      float scale = rs;
      if (gain) {
        float* sG = (float*)(smem + 67584);
        if (tid < 128) sG[tid] = gain[tid];
        GRAW_BARRIER(); asm volatile("" ::: "memory");
        gain = sG;
      }
      if (gain) {
        float ss = 0.f;
#pragma unroll 4
        for (int j = 0; j < 16; ++j) { const f32x4 t = *(const f32x4*)(crow + 4 * j); ss += t[0] * t[0] + t[1] * t[1] + t[2] * t[2] + t[3] * t[3]; }
        ss += __shfl_xor(ss, 1);
        scale = rs * rsqrtf(rs * rs * ss * (1.f / 128.f) + EPS);
      }
      const float* rc = (const float*)(ws + OFF_ROPE) + pos * 16;
      float rcs[16], rsn[16];
#pragma unroll
      for (int j = 0; j < 16; ++j) { rcs[j] = 1.f; rsn[j] = 0.f; }
      if (rope && !half) {
#pragma unroll
        for (int j = 0; j < 4; ++j) {
          const f32x4 c4 = *(const f32x4*)(rc + 4 * j), s4 = *(const f32x4*)(rc + 65536 + 4 * j);
          rcs[4 * j] = c4[0]; rcs[4 * j + 1] = c4[1]; rcs[4 * j + 2] = c4[2]; rcs[4 * j + 3] = c4[3];
          rsn[4 * j] = s4[0]; rsn[4 * j + 1] = s4[1]; rsn[4 * j + 2] = s4[2]; rsn[4 * j + 3] = s4[3];
        }
      }
      const float* pec = (const float*)(ws + OFF_PEC) + aux * 8 * 128;
#pragma unroll 1
      for (int ch = 0; ch < 4; ++ch) {
        const int c0 = cb + ch * 16;
        float v[16];
#pragma unroll
        for (int j = 0; j < 16; ++j) { v[j] = crow[ch * 16 + j] * scale; if (gain) v[j] *= gain[c0 + j]; }
        if (rope && c0 < 32) {
          const int pc = c0 ^ 16;
#pragma unroll
          for (int j = 0; j < 16; ++j) {
            const float pv = sC[r * 132 + pc + j] * scale * gain[pc + j];
            const float c = rcs[j], sn = rsn[j];
            v[j] = (c0 == 0) ? (v[j] * c - pv * sn) : (v[j] * c + pv * sn);
          }
        }
        if (act == 1) {
#pragma unroll
          for (int j = 0; j < 16; ++j) v[j] = sigmoidf_(v[j]);
        } else if (act == 2) {
#pragma unroll
          for (int j = 0; j < 16; ++j) { const float u = fmaxf(v[j], 0.f); v[j] = u * u; }
        } else if (act == 3) {
#pragma unroll
          for (int j = 0; j < 16; ++j) {
            float xx = v[j];
#pragma unroll
            for (int q = 0; q < 8; ++q) xx += pec[q * 128 + c0 + j];
            const float y2 = 2.f * 0.7978845608028654f * (xx + 0.044715f * xx * xx * xx);
            v[j] = xx * (1.f - 1.f / (1.f + __expf(y2)));
          }
        } else if (act == 4) {
#pragma unroll
          for (int j = 0; j < 16; ++j) v[j] = 0.f;
        }
        u32x4 o0 = {pk2(v[0], v[1]), pk2(v[2], v[3]), pk2(v[4], v[5]), pk2(v[6], v[7])};
        u32x4 o1 = {pk2(v[8], v[9]), pk2(v[10], v[11]), pk2(v[12], v[13]), pk2(v[14], v[15])};
        u16* dp = dst + c0; u16* dp2 = dp + 8;
        if (mode == MODE_UP) { dp = dst + blk32(mt, 256, 128, r, nt * 128 + c0); dp2 = dst + blk32(mt, 256, 128, r, nt * 128 + c0 + 8); }
        *(u32x4*)dp = o0; *(u32x4*)dp2 = o1;
      }
    }
  }
}

#define XB_XCNT(j)  (256  + 64 * (j))
#define XB_XSUB(j)  (1280 + 64 * (j))
#define XB_XGEN(j)  (2304 + 64 * (j))
#define XB_TOP      3328
#define XB_TOPGEN   3392
DI unsigned xb_ld(unsigned* p) { return __hip_atomic_load(p, __ATOMIC_RELAXED, __HIP_MEMORY_SCOPE_AGENT); }
DI unsigned xb_add(unsigned* p, unsigned v) { return __hip_atomic_fetch_add(p, v, __ATOMIC_RELAXED, __HIP_MEMORY_SCOPE_AGENT); }
DI unsigned xb_xcc_id() { return (unsigned)__builtin_amdgcn_s_getreg((3 << 11) | 20) & 0xFu; }
DI void xcd_barrier(unsigned* bar, unsigned x, const unsigned* st) {
  asm volatile("s_waitcnt vmcnt(0)" ::: "memory");
  __syncthreads();
  if (threadIdx.x == 0) {
    const unsigned nloc = st[0], nx = st[1];
    const unsigned old = xb_add(&bar[XB_XSUB(x)], 1u);
    const unsigned gen = old / nloc;
    if (old + 1u == (gen + 1u) * nloc) {
      __builtin_amdgcn_fence(__ATOMIC_RELEASE, "agent");
      asm volatile("s_waitcnt vmcnt(0)" ::: "memory");
      const unsigned og = xb_add(&bar[XB_TOP], 1u);
      const unsigned tg = og / nx;
      if (og + 1u == (tg + 1u) * nx) xb_add(&bar[XB_TOPGEN], 1u);
      else while (xb_ld(&bar[XB_TOPGEN]) == tg) __builtin_amdgcn_s_sleep(1);
      __builtin_amdgcn_fence(__ATOMIC_ACQUIRE, "agent");
      xb_add(&bar[XB_XGEN(x)], 1u);
      asm volatile("s_waitcnt vmcnt(0)" ::: "memory");
    } else {
      while (xb_ld(&bar[XB_XGEN(x)]) == gen) __builtin_amdgcn_s_sleep(1);
      __builtin_amdgcn_fence(__ATOMIC_ACQUIRE, "agent");
      asm volatile("s_waitcnt vmcnt(0)" ::: "memory");
    }
  }
  __syncthreads();
}

constexpr int SKS = 272, SVS = 320;
constexpr int LDS_SK = 0, LDS_SV = 17408, LDS_X = 37888;
constexpr float SL2 = SCALE * L2E;

DI s16x4 tr_read(const char* ptr) {
  return __builtin_amdgcn_ds_read_tr16_b64_v4i16((__attribute__((address_space(3))) s16x4*)(ptr));
}
DI float gain_absmax(const float* g) {
  const f32x4* g4 = (const f32x4*)g;
  float m = 0.f;
#pragma unroll 1
  for (int c = 0; c < 4; ++c) {
#pragma unroll
    for (int i = 0; i < 8; ++i) {
      const f32x4 t = g4[c * 8 + i];
      m = fmaxf(m, fmaxf(fmaxf(fabsf(t[0]), fabsf(t[1])), fmaxf(fabsf(t[2]), fabsf(t[3]))));
    }
  }
  return m;
}
template <class PF>
DI void attn_tile(const bf16x8 (&qf)[8], const char* smem, f32x16 (&acc)[4], float& lsum, PF&& pf) {
  const int lane = opaque_tid() & 63, l31 = lane & 31, lh = lane >> 5;
  const int q4 = (lane & 15) >> 2, p4 = lane & 3, blk = (lane >> 4) & 1;
  const char* sK = smem + LDS_SK; const char* sV = smem + LDS_SV;
#pragma unroll 1
  for (int u = 0; u < 2; ++u) {
    f32x16 sc;
#pragma unroll
    for (int i = 0; i < 16; ++i) sc[i] = 0.f;
#pragma unroll
    for (int kh = 0; kh < 2; ++kh) {
      bf16x8 a[4];
#pragma unroll
      for (int k2 = 0; k2 < 4; ++k2) a[k2] = *(const bf16x8*)(sK + (32 * u + l31) * SKS + (16 * (4 * kh + k2) + 8 * lh) * 2);
#pragma unroll
      for (int k2 = 0; k2 < 4; ++k2) sc = mfma32(a[k2], qf[4 * kh + k2], sc);
      __builtin_amdgcn_sched_barrier(0);
    }
    float pr[16];
    pf(u, sc, pr);
#pragma unroll
    for (int i = 0; i < 16; ++i) lsum += pr[i];
#pragma unroll
    for (int s = 0; s < 2; ++s) {
      u32x4 pw = {pk2(pr[8 * s], pr[8 * s + 1]), pk2(pr[8 * s + 2], pr[8 * s + 3]), pk2(pr[8 * s + 4], pr[8 * s + 5]), pk2(pr[8 * s + 6], pr[8 * s + 7])};
      const bf16x8 pb = __builtin_bit_cast(bf16x8, pw);
      bf16x8 a[4];
#pragma unroll
      for (int c = 0; c < 4; ++c) {
        const char* base = sV + (32 * u + 16 * s + 4 * lh + q4) * SVS + (32 * c + 16 * blk) * 2 + 8 * p4;
        const s16x4 lo = tr_read(base), hi = tr_read(base + 8 * SVS);
        a[c] = __builtin_shufflevector(lo, hi, 0, 1, 2, 3, 4, 5, 6, 7);
      }
#pragma unroll
      for (int c = 0; c < 4; ++c) acc[c] = mfma32(a[c], pb, acc[c]);
      __builtin_amdgcn_sched_barrier(0);
    }
  }
}
template <class RF>
DI void kv_load(u32x4 (&rk)[4], u32x4 (&rv)[4], const u16* K, const u16* V, RF&& rowoff) {
  const int tid0 = opaque_tid();
#pragma unroll
  for (int j = 0; j < 4; ++j) {
    const int idx = tid0 + 256 * j, key = idx >> 4, ch = idx & 15;
    const size_t off = rowoff(key) + ch * 8;
    rk[j] = *(const u32x4*)(K + off); rv[j] = *(const u32x4*)(V + off);
  }
}
DI void kv_store(const u32x4 (&rk)[4], const u32x4 (&rv)[4], char* smem) {
  const int tid0 = opaque_tid();
#pragma unroll
  for (int j = 0; j < 4; ++j) {
    const int idx = tid0 + 256 * j, key = idx >> 4, ch = idx & 15;
    *(u32x4*)(smem + LDS_SK + key * SKS + ch * 16) = rk[j];
    *(u32x4*)(smem + LDS_SV + key * SVS + ch * 16) = rv[j];
  }
}
DI void acc_zero(f32x16 (&acc)[4]) {
#pragma unroll
  for (int c = 0; c < 4; ++c)
#pragma unroll
    for (int i = 0; i < 16; ++i) acc[c][i] = 0.f;
}

DI void fox_item(const Params& p, int bh, int qt, char* smem, float mbl2) {
  char* ws = opaque_ptr(p.ws);
  const int tid = opaque_tid(), lane = tid & 63, wid = tid >> 6, l31 = lane & 31, lh = lane >> 5;
  const int b = bh >> 3, h = bh & 7;
  const u16* Q = (const u16*)(ws + OFF_QF) + (size_t)bh * SEQ * 128;
  const u16* K = (const u16*)(ws + OFF_KF) + (size_t)bh * SEQ * 128;
  const u16* V = (const u16*)(ws + OFF_VF) + (size_t)bh * SEQ * 128;
  u16* O = (u16*)(ws + OFF_OB) + (size_t)(b * 16 + h) * SEQ * 128;
  const float* lf = (const float*)(ws + OFF_LOGF) + (size_t)bh * SEQ;
  float* sCum = (float*)(smem + LDS_X);
  float* wtot = sCum + 4096;
  const int n = 128 * (qt + 1);
  __syncthreads();
  {
    float loc[16]; float tot = 0.f;
    const bool act = 16 * tid < n;
    if (act) {
#pragma unroll
      for (int j = 0; j < 4; ++j) {
        const f32x4 t = *(const f32x4*)(lf + 16 * tid + 4 * j);
        tot += t[0]; loc[4 * j] = tot; tot += t[1]; loc[4 * j + 1] = tot; tot += t[2]; loc[4 * j + 2] = tot; tot += t[3]; loc[4 * j + 3] = tot;
      }
    }
    float inc = tot;
#pragma unroll
    for (int o = 1; o < 64; o <<= 1) { const float y = __shfl_up(inc, o); if (lane >= o) inc += y; }
    if (lane == 63) wtot[wid] = inc;
    __syncthreads();
    float base = inc - tot;
    for (int w = 0; w < wid; ++w) base += wtot[w];
    if (act) {
#pragma unroll
      for (int j = 0; j < 16; ++j) sCum[16 * tid + j] = (base + loc[j]) * L2E;
    }
  }
  const int qrow = qt * 128 + wid * 32 + l31;
  bf16x8 qf[8];
#pragma unroll
  for (int ks = 0; ks < 8; ++ks) qf[ks] = *(const bf16x8*)(Q + (size_t)qrow * 128 + 16 * ks + 8 * lh);
  f32x16 acc[4]; acc_zero(acc);
  float lsum = 0.f;
  const int ntiles = 2 * (qt + 1);
  u32x4 rk[4], rv[4];
  __syncthreads();
  const float cq = sCum[qrow] - mbl2;
  int t0 = 0;
  {
    const float cq0 = sCum[qt * 128];
    int lo = 0, hi = ntiles - 2;
    while (lo < hi) { const int mid = (lo + hi) >> 1; if (cq0 - sCum[64 * mid + 63] < -160.f) lo = mid + 1; else hi = mid; }
    t0 = lo;
  }
  { const int k00 = 64 * t0; kv_load(rk, rv, K, V, [&](int key) { return (size_t)(k00 + key) * 128; }); }
  const int wqmax = qt * 128 + wid * 32 + 31;
  for (int t = t0; t < ntiles; ++t) {
    __syncthreads();
    kv_store(rk, rv, smem);
    if (t + 1 < ntiles) { const int k0n = 64 * (t + 1); kv_load(rk, rv, K, V, [&](int key) { return (size_t)(k0n + key) * 128; }); }
    __syncthreads();
    const int key0 = 64 * t;
    if (key0 + 63 <= wqmax - 31) {
      attn_tile(qf, smem, acc, lsum, [&](int u, const f32x16& sc, float (&pr)[16]) {
#pragma unroll
        for (int g = 0; g < 4; ++g) {
          const f32x4 ck = *(const f32x4*)(sCum + key0 + 32 * u + 8 * g + 4 * lh);
#pragma unroll
          for (int e = 0; e < 4; ++e) pr[4 * g + e] = __builtin_amdgcn_exp2f(sc[4 * g + e] * SL2 + (cq - ck[e]));
        }
      });
    } else if (key0 <= wqmax) {
      attn_tile(qf, smem, acc, lsum, [&](int u, const f32x16& sc, float (&pr)[16]) {
#pragma unroll
        for (int g = 0; g < 4; ++g) {
          const int kb = key0 + 32 * u + 8 * g + 4 * lh;
          const f32x4 ck = *(const f32x4*)(sCum + kb);
#pragma unroll
          for (int e = 0; e < 4; ++e) {
            const float arg = sc[4 * g + e] * SL2 + (cq - ck[e]);
            pr[4 * g + e] = (kb + e <= qrow) ? __builtin_amdgcn_exp2f(arg) : 0.f;
          }
        }
      });
    }
  }
  const float l = lsum + __shfl_xor(lsum, 32);
  const float inv = 1.f / l;
#pragma unroll
  for (int c = 0; c < 4; ++c)
#pragma unroll
    for (int g = 0; g < 4; ++g) {
      u16* op = O + (size_t)qrow * 128 + 32 * c + 8 * g + 4 * lh;
      const u32x2 gt = *(const u32x2*)op;
      u32x2 o = {pk2(acc[c][4 * g] * inv * bflo(gt[0]), acc[c][4 * g + 1] * inv * bfhi(gt[0])),
                 pk2(acc[c][4 * g + 2] * inv * bflo(gt[1]), acc[c][4 * g + 3] * inv * bfhi(gt[1]))};
      *(u32x2*)op = o;
    }
}

DI void dil_item(const Params& p, int pat, int bh, int sub, char* smem, float mbl2) {
  char* ws = opaque_ptr(p.ws);
  const int tid = opaque_tid(), lane = tid & 63, wid = tid >> 6, l31 = lane & 31, lh = lane >> 5;
  const int b = bh >> 3, h = bh & 7;
  const int dsh = 2 * pat, d = 1 << dsh, tpr = 32 >> dsh;
  const int res = sub / tpr, tile = sub % tpr;
  const u16* Q = (const u16*)(ws + OFF_QD) + (size_t)bh * SEQ * 128;
  const u16* K = (const u16*)(ws + OFF_KD) + (size_t)bh * SEQ * 128;
  const u16* V = (const u16*)(ws + OFF_VD) + (size_t)bh * SEQ * 128;
  u16* O = (u16*)(ws + OFF_OB) + (size_t)(b * 16 + 8 + h) * SEQ * 128;
  float* den = (float*)(ws + OFF_DILDEN) + (size_t)bh * SEQ;
  const int qm = tile * 128 + wid * 32 + l31, qtok = qm * d + res;
  bf16x8 qf[8];
#pragma unroll
  for (int ks = 0; ks < 8; ++ks) qf[ks] = *(const bf16x8*)(Q + (size_t)qtok * 128 + 16 * ks + 8 * lh);
  f32x16 acc[4]; acc_zero(acc);
  float lsum = 0.f;
  const int jlo = (tile == 0) ? 2 : 0;
  const int wq0 = tile * 128 + wid * 32;
  u32x4 rk[4], rv[4];
  auto rowf = [&](int km0) { return [=](int key) { int km = km0 + key; km = km < 0 ? 0 : km; return (size_t)(km * d + res) * 128; }; };
  kv_load(rk, rv, K, V, rowf(tile * 128 - 128 + 64 * jlo));
  for (int j = jlo; j < 4; ++j) {
    __syncthreads();
    kv_store(rk, rv, smem);
    if (j + 1 < 4) kv_load(rk, rv, K, V, rowf(tile * 128 - 128 + 64 * (j + 1)));
    __syncthreads();
    const int km0 = tile * 128 - 128 + 64 * j;
    if (km0 + 63 >= wq0 - 128 && km0 <= wq0 + 31) {
      attn_tile(qf, smem, acc, lsum, [&](int u, const f32x16& sc, float (&pr)[16]) {
#pragma unroll
        for (int i = 0; i < 16; ++i) {
          const int km = km0 + 32 * u + 8 * (i >> 2) + 4 * lh + (i & 3);
          const int dist = qm - km;
          pr[i] = (km >= 0 && dist >= 0 && dist <= 128) ? __builtin_amdgcn_exp2f(sc[i] * SL2 - mbl2) : 0.f;
        }
      });
    }
  }
  float l = lsum + __shfl_xor(lsum, 32);
  if (pat > 0) l += den[qtok];
  if (pat < 2) { if (lh == 0) den[qtok] = l; }
  const float inv = (pat == 2) ? 1.f / l : 1.f;
#pragma unroll
  for (int c = 0; c < 4; ++c)
#pragma unroll
    for (int g = 0; g < 4; ++g) {
      u16* op = O + (size_t)qtok * 128 + 32 * c + 8 * g + 4 * lh;
      float a0 = acc[c][4 * g], a1 = acc[c][4 * g + 1], a2 = acc[c][4 * g + 2], a3 = acc[c][4 * g + 3];
      if (pat > 0) { const u32x2 pv = *(const u32x2*)op; a0 += bflo(pv[0]); a1 += bfhi(pv[0]); a2 += bflo(pv[1]); a3 += bfhi(pv[1]); }
      u32x2 o = {pk2(a0 * inv, a1 * inv), pk2(a2 * inv, a3 * inv)};
      *(u32x2*)op = o;
    }
}

DI void phase_attn0(const Params& p, char* smem, int sub) {
  if (sub == 0) {
    const float mb = SCALE * 128.f * gain_absmax(p.e_gq_fox) * gain_absmax(p.e_gk_fox) * 1.02f * L2E;
    for (int j = blockIdx.x; j < 512; j += gridDim.x) {
#pragma unroll 1
      for (int k = 0; k < 2; ++k) {
        const int j2 = k ? 1023 - j : j;
        fox_item(p, j2 & 31, 31 - (j2 >> 5), smem, mb);
      }
    }
  }
  const float mbd = SCALE * 128.f * gain_absmax(p.e_gq_dil) * gain_absmax(p.e_gk_dil) * 1.02f * L2E;
  for (int i = blockIdx.x; i < 1024; i += gridDim.x) dil_item(p, sub, i >> 5, i & 31, smem, mbd);
}


constexpr int LDS_BS = LDS_X;
constexpr int LDS_LC = LDS_BS + 32768;
constexpr int LDS_SEL = LDS_LC + 512;
constexpr float NEGV = -1e30f;

DI void nsa_stash(u16* O, const f32x16 (&acc)[4], float sc, bool first, int lh) {
#pragma unroll
  for (int c = 0; c < 4; ++c)
#pragma unroll
    for (int g = 0; g < 4; ++g) {
      u16* op = O + 32 * c + 8 * g + 4 * lh;
      float a0 = acc[c][4 * g] * sc, a1 = acc[c][4 * g + 1] * sc, a2 = acc[c][4 * g + 2] * sc, a3 = acc[c][4 * g + 3] * sc;
      if (!first) { const u32x2 pv = *(const u32x2*)op; a0 += bflo(pv[0]); a1 += bfhi(pv[0]); a2 += bflo(pv[1]); a3 += bfhi(pv[1]); }
      u32x2 o = {pk2(a0, a1), pk2(a2, a3)};
      *(u32x2*)op = o;
    }
}

DI void nsa_item(const Params& p, int bg, int qt, char* smem, float mbc, float mbs, float mbw) {
  char* ws = opaque_ptr(p.ws);
  const int tid = opaque_tid(), lane = tid & 63, wid = tid >> 6, l31 = lane & 31, lh = lane >> 5;
  const int b = bg >> 2, g = bg & 3;
  const int q0 = qt * 32, t = q0 + l31;
  u16* QO = (u16*)(ws + OFF_QN) + ((size_t)(b * 16 + g * 4 + wid) * SEQ + t) * 128;
  const float* gt = (const float*)(ws + OFF_GATES) + (size_t)(b * SEQ + t) * 48 + g * 12 + wid * 3;
  const float g0 = gt[0], g1 = gt[1], g2 = gt[2];
  float* BS = (float*)(smem + LDS_BS);
  float* LC = (float*)(smem + LDS_LC);
  unsigned* SEL = (unsigned*)(smem + LDS_SEL);
  bf16x8 qf[8];
#pragma unroll
  for (int ks = 0; ks < 8; ++ks) qf[ks] = *(const bf16x8*)(QO + 16 * ks + 8 * lh);
  __syncthreads();
  for (int i = tid; i < 8192; i += 256) BS[i] = 0.f;
  f32x16 acc[4]; acc_zero(acc);
  float lsum = 0.f;
  u32x4 rk[4], rv[4];
  {
    const u16* K = (const u16*)(ws + OFF_KC) + (size_t)bg * 256 * 128;
    const u16* V = (const u16*)(ws + OFF_VC) + (size_t)bg * 256 * 128;
    const int ntiles = ((q0 >> 4) >> 6) + 1;
    float carry = 0.f;
    kv_load(rk, rv, K, V, [&](int key) { return (size_t)key * 128; });
    for (int tl = 0; tl < ntiles; ++tl) {
      __syncthreads();
      kv_store(rk, rv, smem);
      if (tl + 1 < ntiles) { const int n0n = 64 * (tl + 1); kv_load(rk, rv, K, V, [&](int key) { return (size_t)(n0n + key) * 128; }); }
      __syncthreads();
      const int n0 = 64 * tl;
      attn_tile(qf, smem, acc, lsum, [&](int u, const f32x16& sc, float (&pr)[16]) {
        float G[4], last[4];
#pragma unroll
        for (int a = 0; a < 4; ++a) {
          float gs = 0.f;
#pragma unroll
          for (int e = 0; e < 4; ++e) {
            const int n = n0 + 32 * u + 8 * a + 4 * lh + e;
            const float pv = (16 * n + 31 <= t) ? __builtin_amdgcn_exp2f(sc[4 * a + e] * SL2 - mbc) : 0.f;
            pr[4 * a + e] = pv; gs += pv;
          }
          G[a] = gs; last[a] = pr[4 * a + 3];
        }
        float x[4];
#pragma unroll
        for (int a = 0; a < 4; ++a) x[a] = __shfl_xor(last[a], 32);
        const int jb = (n0 + 32 * u) >> 2;
#pragma unroll
        for (int a = 0; a < 4; ++a) {
          const float add = lh ? x[a] : (a ? x[a > 0 ? a - 1 : 0] : carry);
          BS[(wid * 32 + l31) * 64 + jb + 2 * a + lh] = G[a] + add;
        }
        carry = x[3];
      });
    }
    const float l = lsum + __shfl_xor(lsum, 32);
    if (lh == 0) LC[wid * 32 + l31] = l;
    nsa_stash(QO, acc, l > 0.f ? g0 / l : 0.f, true, lh);
  }
  __syncthreads();
  for (int i = tid; i < 2048; i += 256) {
    const int q = i >> 6, j = i & 63;
    float imp = 0.f;
#pragma unroll
    for (int w = 0; w < 4; ++w) { const float l = LC[w * 32 + q]; imp += (l > 0.f) ? BS[(w * 32 + q) * 64 + j] / l : 0.f; }
    const int cur = (q0 + q) >> 6;
    if (j == 0 || j == cur || j == cur - 1) imp = 1e9f;
    if (j > cur) imp = NEGV;
    BS[q * 64 + j] = imp;
  }
  __syncthreads();
  for (int rep = 0; rep < 8; ++rep) {
    const int q = rep * 4 + wid, j = lane;
    const float v = BS[q * 64 + j];
    int rank = 0;
    for (int k = 0; k < 64; ++k) { const float o = BS[q * 64 + k]; rank += (o > v || (o == v && k < j)) ? 1 : 0; }
    const unsigned long long m = __ballot(rank < 16 && v > 0.5f * NEGV);
    if (lane == 0) { SEL[q * 2] = (unsigned)m; SEL[q * 2 + 1] = (unsigned)(m >> 32); }
  }
  __syncthreads();
  unsigned long long umask = 0;
  for (int q = 0; q < 32; ++q) umask |= (unsigned long long)SEL[q * 2] | ((unsigned long long)SEL[q * 2 + 1] << 32);
  const unsigned long long mymask = (unsigned long long)SEL[l31 * 2] | ((unsigned long long)SEL[l31 * 2 + 1] << 32);
  {
    const u16* K = (const u16*)(ws + OFF_KS) + (size_t)bg * SEQ * 128;
    const u16* V = (const u16*)(ws + OFF_VS) + (size_t)bg * SEQ * 128;
    acc_zero(acc); lsum = 0.f;
    unsigned long long rem = umask;
    int j = __builtin_ctzll(rem); rem &= rem - 1;
    { const int k0 = 64 * j; kv_load(rk, rv, K, V, [&](int key) { return (size_t)(k0 + key) * 128; }); }
    while (true) {
      __syncthreads();
      kv_store(rk, rv, smem);
      const int jn = rem ? __builtin_ctzll(rem) : -1;
      if (jn >= 0) { rem &= rem - 1; const int k0 = 64 * jn; kv_load(rk, rv, K, V, [&](int key) { return (size_t)(k0 + key) * 128; }); }
      __syncthreads();
      const bool mine = (mymask >> j) & 1;
      const int key0 = 64 * j;
      if (key0 + 63 <= q0) {
        attn_tile(qf, smem, acc, lsum, [&](int u, const f32x16& sc, float (&pr)[16]) {
#pragma unroll
          for (int i = 0; i < 16; ++i) pr[i] = mine ? __builtin_amdgcn_exp2f(sc[i] * SL2 - mbs) : 0.f;
        });
      } else {
        attn_tile(qf, smem, acc, lsum, [&](int u, const f32x16& sc, float (&pr)[16]) {
#pragma unroll
          for (int i = 0; i < 16; ++i) {
            const int key = key0 + 32 * u + 8 * (i >> 2) + 4 * lh + (i & 3);
            pr[i] = (mine && key <= t) ? __builtin_amdgcn_exp2f(sc[i] * SL2 - mbs) : 0.f;
          }
        });
      }
      if (jn < 0) break;
      j = jn;
    }
    const float l = lsum + __shfl_xor(lsum, 32);
    nsa_stash(QO, acc, l > 0.f ? g1 / l : 0.f, false, lh);
  }
  {
    const u16* K = (const u16*)(ws + OFF_KW) + (size_t)bg * SEQ * 128;
    const u16* V = (const u16*)(ws + OFF_VW) + (size_t)bg * SEQ * 128;
    acc_zero(acc); lsum = 0.f;
    const int tlo = (q0 >= 511 ? q0 - 511 : 0) >> 6, thi = (q0 + 31) >> 6;
    { const int k0 = 64 * tlo; kv_load(rk, rv, K, V, [&](int key) { return (size_t)(k0 + key) * 128; }); }
    for (int tl = tlo; tl <= thi; ++tl) {
      __syncthreads();
      kv_store(rk, rv, smem);
      if (tl + 1 <= thi) { const int k0 = 64 * (tl + 1); kv_load(rk, rv, K, V, [&](int key) { return (size_t)(k0 + key) * 128; }); }
      __syncthreads();
      const int key0 = 64 * tl;
      if (key0 + 63 <= q0 && key0 >= q0 + 31 - 511) {
        attn_tile(qf, smem, acc, lsum, [&](int u, const f32x16& sc, float (&pr)[16]) {
#pragma unroll
          for (int i = 0; i < 16; ++i) pr[i] = __builtin_amdgcn_exp2f(sc[i] * SL2 - mbw);
        });
      } else {
        attn_tile(qf, smem, acc, lsum, [&](int u, const f32x16& sc, float (&pr)[16]) {
#pragma unroll
          for (int i = 0; i < 16; ++i) {
            const int dist = t - (key0 + 32 * u + 8 * (i >> 2) + 4 * lh + (i & 3));
            pr[i] = (dist >= 0 && dist < 512) ? __builtin_amdgcn_exp2f(sc[i] * SL2 - mbw) : 0.f;
          }
        });
      }
    }
    const float l = lsum + __shfl_xor(lsum, 32);
    nsa_stash(QO, acc, l > 0.f ? g2 / l : 0.f, false, lh);
  }
}

DI void phase_nsa(const Params& p, char* smem) {
  const float gq = gain_absmax(p.o_gq) * SCALE * 128.f * 1.02f * L2E;
  const float mbc = gq * gain_absmax(p.o_gkc), mbs = gq * gain_absmax(p.o_gks), mbw = gq * gain_absmax(p.o_gkw);
  for (int j = blockIdx.x; j < 1024; j += gridDim.x) {
#pragma unroll 1
    for (int k = 0; k < 2; ++k) {
      const int j2 = k ? 2047 - j : j;
      nsa_item(p, j2 & 15, 127 - (j2 >> 4), smem, mbc, mbs, mbw);
    }
  }
}

DI void zero_buf(char* ptr, size_t bytes) {
  u32x4 z = {0, 0, 0, 0};
  u32x4* o = (u32x4*)ptr;
  for (size_t i = (size_t)blockIdx.x * 256 + threadIdx.x; i < bytes / 16; i += (size_t)gridDim.x * 256) o[i] = z;
}

constexpr int N_PHASES = 16;
__global__ void __launch_bounds__(256, 2) mega(Params p) {
  __shared__ __attribute__((aligned(16))) char smem[SMEM_BYTES];
  __shared__ unsigned xbst[4];
  char* ws = p.ws;
  if (threadIdx.x == 0) xb_add(&((unsigned*)(ws + OFF_BAR))[XB_XCNT(xb_xcc_id())], 1u);
  for (int ph = p.phase_lo; ph <= p.phase_hi; ++ph) {
    size_t offA = 0, offB = 0; int lda = DM, K = DM, tiles_n = 0, mode = -1, aux = 0, headmajor = 0;
    switch (ph) {
      case 1: offA = OFF_HB; offB = OFF_WT_IN; tiles_n = 57; mode = MODE_IN0; break;
      case 5: offA = OFF_OB; offB = OFF_WT_OUT; tiles_n = 16; mode = MODE_OUT0; headmajor = 1; break;
      case 6: offA = OFF_HB; offB = OFF_WT_UP; tiles_n = 64; mode = MODE_UP; break;
      case 7: offA = OFF_ACT; offB = OFF_WT_DN; lda = DFF; K = DFF; tiles_n = 16; mode = MODE_DOWN; break;
      case 9: offA = OFF_HB; offB = OFF_WT_IN; tiles_n = 41; mode = MODE_IN1; break;
      case 10: mode = MODE_C1; break;
      case 11: mode = MODE_C2; break;
      case 13: offA = OFF_QN; offB = OFF_WT_OUT; tiles_n = 16; mode = MODE_DOWN; headmajor = 1; break;
      case 14: offA = OFF_HB; offB = OFF_WT_UP; tiles_n = 64; mode = MODE_UP; break;
      case 15: offA = OFF_ACT; offB = OFF_WT_DN; lda = DFF; K = DFF; tiles_n = 16; mode = MODE_DOWN; aux = 1; break;
      default: break;
    }
    if (mode >= 0) {
      const int tiles_n2 = (tiles_n + 1) >> 1;
      const int total = (mode == MODE_C1) ? 256 : (mode == MODE_C2) ? 64 : 128 * tiles_n2;
      for (int i = blockIdx.x; i < total; i += gridDim.x) {
        const u16 *A, *Bt; size_t la, lb, hs = 128; bool ablk = false, bblk = false; int kk, mt, nt, ax, ntl = 1;
        if (mode == MODE_C1) {
          const int ksp = i & 3, r2 = i >> 2, kv = r2 >> 5; mt = r2 & 31; nt = 0; ax = kv | (ksp << 1);
          A = (const u16*)(ws + (kv ? OFF_VCR : OFF_KCR)) + (size_t)(mt >> 1) * SEQ * 128 + (size_t)(mt & 1) * 128 * 2048 + ksp * 1024;
          Bt = (const u16*)(ws + OFF_W1T + (size_t)kv * MiB) + ksp * 1024; la = 2048; lb = 4096; kk = 1024;
        } else if (mode == MODE_C2) {
          const int kv = i >> 5; mt = i & 31; nt = 0; ax = kv;
          A = (const u16*)(ws + OFF_HID + (size_t)kv * MiB) + (size_t)mt * 128 * 128;
          Bt = (const u16*)(ws + OFF_W2T + (size_t)kv * 32768); la = 128; lb = 128; kk = 128;
          {
            const int tid = opaque_tid(), r = tid >> 1, cb = (tid & 1) * 64, row = mt * 128 + r;
            const float* pec = (const float*)(ws + OFF_PEC) + kv * 8 * 128;
            u16* hd = (u16*)(ws + OFF_HID + (size_t)kv * MiB) + (size_t)row * 128 + cb;
#pragma unroll 1
            for (int ch = 0; ch < 4; ++ch) {
              float v[16];
#pragma unroll
              for (int j = 0; j < 16; ++j) v[j] = 0.f;
#pragma unroll
              for (int q = 0; q < 4; ++q) {
                const float* pp = (const float*)(ws + OFF_PART) + ((size_t)(kv | (q << 1)) * 4096 + row) * 128 + cb + ch * 16;
#pragma unroll
                for (int j = 0; j < 4; ++j) { const f32x4 t = *(const f32x4*)(pp + 4 * j); v[4 * j] += t[0]; v[4 * j + 1] += t[1]; v[4 * j + 2] += t[2]; v[4 * j + 3] += t[3]; }
              }
#pragma unroll
              for (int j = 0; j < 16; ++j) {
                float xx = v[j];
#pragma unroll
                for (int q = 0; q < 8; ++q) xx += pec[q * 128 + cb + ch * 16 + j];
                const float y2 = 2.f * 0.7978845608028654f * (xx + 0.044715f * xx * xx * xx);
                v[j] = xx * (1.f - 1.f / (1.f + __expf(y2)));
              }
              u32x4 o0 = {pk2(v[0], v[1]), pk2(v[2], v[3]), pk2(v[4], v[5]), pk2(v[6], v[7])};
              u32x4 o1 = {pk2(v[8], v[9]), pk2(v[10], v[11]), pk2(v[12], v[13]), pk2(v[14], v[15])};
              *(u32x4*)(hd + ch * 16) = o0; *(u32x4*)(hd + ch * 16 + 8) = o1;
            }
            __syncthreads();
          }
        } else {
          const int x = i & 7, seq = i >> 3;
          mt = x * 16 + (seq & 15); nt = seq >> 4; ax = aux; kk = K; ntl = tiles_n;
          const size_t nkk = (size_t)(K >> 6);
          if (headmajor) {
            la = 128; hs = (size_t)SEQ * 128;
            A = (const u16*)(ws + offA) + ((size_t)(mt >> 5) * 16 * SEQ + (size_t)(mt & 31) * 128) * 128;
          } else {
            la = 0; ablk = true;
            A = (const u16*)(ws + offA) + (size_t)mt * (nkk * 2) * 4096;
          }
          lb = 0; bblk = true;
          Bt = (const u16*)(ws + offB) + (size_t)nt * (nkk * 2) * 8192;
        }
        gemm_tile(p, A, la, hs, ablk, Bt, lb, bblk, kk, mode, mt, nt, ntl, ax, smem);
      }
    } else {
      switch (ph) {
        case 0: phase_prep(p, smem, 0); break;
        case 2: phase_attn0(p, smem, 0); break;
        case 3: phase_attn0(p, smem, 1); break;
        case 4: phase_attn0(p, smem, 2); break;
        case 8: phase_prep(p, smem, 1); break;
        case 12: phase_nsa(p, smem); break;
        default: break;
      }
    }
    if (ph < p.phase_hi) {
      unsigned* xbar = (unsigned*)(opaque_ptr(p.ws) + OFF_BAR);
      const unsigned xcc = xb_xcc_id();
      if (ph == p.phase_lo) {
        cg::this_grid().sync();
        if (threadIdx.x == 0) {
          unsigned mine = 0, cnt = 0;
          for (unsigned j = 0; j < 16; ++j) { const unsigned c = xb_ld(&xbar[XB_XCNT(j)]); cnt += (c > 0u) ? 1u : 0u; mine = (j == xcc) ? c : mine; }
          xbst[0] = mine > 0u ? mine : 1u; xbst[1] = cnt > 0u ? cnt : 1u;
        }
        __syncthreads();
      } else xcd_barrier(xbar, xcc, xbst);
    }
  }
}

__global__ void report_ws(float* out, int n, float val) {
  for (int i = blockIdx.x * 256 + threadIdx.x; i < n; i += gridDim.x * 256) out[i] = (i == 0) ? val : 0.f;
}

extern "C" void kernel_launch(void* const* d_in, const int* in_sizes, int n_in, void* d_out, int out_size, void* d_ws, size_t ws_size,
                              hipStream_t stream) {
  static int grid_blocks = 0;
  if (!grid_blocks) {
    int dev = 0, cus = 0, per_cu = 0;
    hipGetDevice(&dev);
    hipDeviceGetAttribute(&cus, hipDeviceAttributeMultiprocessorCount, dev);
    hipOccupancyMaxActiveBlocksPerMultiprocessor(&per_cu, mega, 256, 0);
    if (per_cu > 2) per_cu = 2;
    if (per_cu < 1) per_cu = 1;
    grid_blocks = cus * per_cu;
  }
  Params p{};
  const float** f = (const float**)&p;
  for (int i = 0; i < 24; ++i) f[i] = (const float*)d_in[i];
  p.out = (float*)d_out; p.ws = (char*)d_ws;
  if (ws_size < WS_NEED) {
    fprintf(stderr, "workspace too small: %zu < %zu\n", ws_size, (size_t)WS_NEED);
    hipLaunchKernelGGL(report_ws, dim3(1024), dim3(256), 0, stream, (float*)d_out, out_size, (float)(ws_size / 1000000));
    return;
  }
  hipMemsetAsync((char*)d_ws + OFF_BAR, 0, 16384, stream);
#if MULTI_LAUNCH
  for (int ph = 0; ph < N_PHASES; ++ph) {
    p.phase_lo = ph; p.phase_hi = ph;
    hipLaunchKernelGGL(mega, dim3(grid_blocks), dim3(256), 0, stream, p);
  }
#else
  p.phase_lo = 0; p.phase_hi = N_PHASES - 1;
  void* args[] = {&p};
  hipError_t e = hipLaunchCooperativeKernel((void*)mega, dim3(grid_blocks), dim3(256), args, 0, stream);
  if (e != hipSuccess) fprintf(stderr, "cooperative launch failed: %s (grid %d)\n", hipGetErrorString(e), grid_blocks);
#endif
}
```
